# Optimizing an MI355X kernel written in HIP

```python
import math
import jax, jax.numpy as jnp
from jax import lax
import numpy as np

D_MODEL = 2048
BATCH = 4
SEQ = 4096
DEPTH = 1

CHUNK = 64
D_FF = 5632
P_DIM = 256
SGU_BLOCK = 128
SGU_GROUPS = 8
SGU_GROUP_DIM = 128
SGU_WIDTH = SGU_GROUPS * SGU_GROUP_DIM
N_HEADS = 8
HEAD_DIM = 64
V_HEAD_DIM = 2 * HEAD_DIM
QK_WIDTH = N_HEADS * 2 * HEAD_DIM
ATTN_WIDTH = N_HEADS * V_HEAD_DIM
Q_BLOCK = 128
IN_COLS = 2 * SGU_WIDTH + 2 * QK_WIDTH + ATTN_WIDTH + 2 * D_MODEL
ALPHA = (2 * DEPTH) ** 0.25
BETA = (8 * DEPTH) ** -0.25
LN_EPS = 1e-5

kernel_name = "hybrid_gmlp_diffattn_macaron_deepnorm"


def layer_norm(x, g, b):
    xf = x.astype(jnp.float32)
    mu = jnp.mean(xf, axis=-1, keepdims=True)
    var = jnp.mean(jnp.square(xf - mu), axis=-1, keepdims=True)
    y = (xf - mu) * lax.rsqrt(var + LN_EPS)
    return (y * g.astype(jnp.float32) + b.astype(jnp.float32)).astype(x.dtype)


def swiglu(x, w_gu, w_down):
    gate, up = jnp.split(x @ w_gu, 2, axis=-1)
    return (jax.nn.silu(gate) * up) @ w_down


def gmlp_sgu(u, v, ln_g, ln_b, w_s, b_s):
    B, S, _ = u.shape
    v = layer_norm(v, ln_g, ln_b)
    pos = jnp.arange(SGU_BLOCK)
    allowed = (pos[None, :] // CHUNK) <= (pos[:, None] // CHUNK)
    w = jnp.where(allowed[None], w_s, jnp.zeros_like(w_s))
    vb = v.reshape(B, S // SGU_BLOCK, SGU_BLOCK, SGU_GROUPS, SGU_GROUP_DIM)
    s = jnp.einsum('gts,bnsgc->bntgc', w, vb) + b_s.T[None, None, :, :, None]
    return u * s.reshape(B, S, SGU_WIDTH)


def diff_attention(q, k, v, lam, slopes):
    B, S, H = q.shape[0], q.shape[1], q.shape[2]
    nq = S // Q_BLOCK
    scale = HEAD_DIM ** -0.5
    qb = q.reshape(B, nq, Q_BLOCK, H, 2, HEAD_DIM).transpose(1, 0, 2, 3, 4, 5)
    kpos = jnp.arange(S)

    def block(args):
        qi, qblk = args
        tpos = qi * Q_BLOCK + jnp.arange(Q_BLOCK)
        s = jnp.einsum('bqhmd,bkhmd->bhmqk', qblk, k).astype(jnp.float32) * scale
        dist = jnp.abs(tpos[:, None] - kpos[None, :]).astype(jnp.float32)
        allowed = (kpos[None, :] // CHUNK) <= (tpos[:, None] // CHUNK)
        s = s - slopes[None, :, None, None, None] * dist
        s = jnp.where(allowed, s, -jnp.inf)
        probs = jax.nn.softmax(s, axis=-1)
        a = probs[:, :, 0] - lam * probs[:, :, 1]
        return jnp.einsum('bhqk,bkhe->bqhe', a.astype(v.dtype), v)

    out = lax.map(block, (jnp.arange(nq), qb))
    return out.transpose(1, 0, 2, 3, 4).reshape(B, S, H, V_HEAD_DIM)


def head_rms_norm(o, g):
    of = o.astype(jnp.float32)
    y = of * lax.rsqrt(jnp.mean(jnp.square(of), axis=-1, keepdims=True) + LN_EPS)
    return (y * g.reshape(N_HEADS, V_HEAD_DIM).astype(jnp.float32)).astype(o.dtype)


def setup_inputs(seed: int = 0) -> dict:
    key = jax.random.key(seed)
    ks = iter(jax.random.split(key, 40))
    f32 = jnp.float32
    L = DEPTH

    def nrm(shape, scale):
        return jax.random.normal(next(ks), shape, f32) * scale

    def gain(shape):
        return 1.0 + nrm(shape, 0.05)

    def bias(shape):
        return nrm(shape, 0.02)

    return {
        "x": nrm((BATCH, SEQ, D_MODEL), 1.0),
        "p": nrm((DEPTH, BATCH, SEQ, P_DIM), 1.0),
        "ffn1_w_gu": nrm((L, D_MODEL, 2 * D_FF), D_MODEL ** -0.5),
        "ffn1_w_down": nrm((L, D_FF, D_MODEL), BETA * D_FF ** -0.5),
        "ln1_g": gain((L, D_MODEL)),
        "ln1_b": bias((L, D_MODEL)),
        "w_in": nrm((L, D_MODEL, IN_COLS), D_MODEL ** -0.5),
        "sgu_ln_g": gain((L, SGU_WIDTH)),
        "sgu_ln_b": bias((L, SGU_WIDTH)),
        "sgu_w": nrm((L, SGU_GROUPS, SGU_BLOCK, SGU_BLOCK), SGU_BLOCK ** -0.5),
        "sgu_b": 1.0 + nrm((L, SGU_GROUPS, SGU_BLOCK), 0.1),
        "lam_q1": nrm((L, HEAD_DIM), 0.1),
        "lam_k1": nrm((L, HEAD_DIM), 0.1),
        "lam_q2": nrm((L, HEAD_DIM), 0.1),
        "lam_k2": nrm((L, HEAD_DIM), 0.1),
        "attn_norm_g": gain((L, ATTN_WIDTH)),
        "w_branch_a": nrm((L, SGU_WIDTH, D_MODEL), SGU_WIDTH ** -0.5),
        "w_branch_b": nrm((L, ATTN_WIDTH, D_MODEL), ATTN_WIDTH ** -0.5),
        "w_out": nrm((L, D_MODEL, D_MODEL), BETA * D_MODEL ** -0.5),
        "ln2_g": gain((L, D_MODEL)),
        "ln2_b": bias((L, D_MODEL)),
        "ffn2_w_gu": nrm((L, D_MODEL, 2 * D_FF), D_MODEL ** -0.5),
        "ffn2_w_down": nrm((L, D_FF, D_MODEL), BETA * D_FF ** -0.5),
        "ln3_g": gain((L, D_MODEL)),
        "ln3_b": bias((L, D_MODEL)),
        "w_pe_gate": nrm((L, D_MODEL, D_MODEL), D_MODEL ** -0.5),
        "w_pe_proj": nrm((L, P_DIM, D_MODEL), BETA * P_DIM ** -0.5),
        "ln4_g": gain((L, D_MODEL)),
        "ln4_b": bias((L, D_MODEL)),
    }


def reference(x, p, ffn1_w_gu, ffn1_w_down, ln1_g, ln1_b, w_in, sgu_ln_g, sgu_ln_b,
              sgu_w, sgu_b, lam_q1, lam_k1, lam_q2, lam_k2, attn_norm_g, w_branch_a,
              w_branch_b, w_out, ln2_g, ln2_b, ffn2_w_gu, ffn2_w_down, ln3_g, ln3_b,
              w_pe_gate, w_pe_proj, ln4_g, ln4_b):
    B, S, _ = x.shape
    slopes = jnp.asarray(2.0 ** (-8.0 * np.arange(1, N_HEADS + 1) / N_HEADS), dtype=jnp.float32)
    splits = np.cumsum([SGU_WIDTH, SGU_WIDTH, QK_WIDTH, QK_WIDTH, ATTN_WIDTH, D_MODEL]).tolist()
    for i in range(DEPTH):
        lam_init = 0.8 - 0.6 * math.exp(-0.3 * i)
        x = layer_norm(ALPHA * x + 0.5 * swiglu(x, ffn1_w_gu[i], ffn1_w_down[i]), ln1_g[i], ln1_b[i])
        proj = x @ w_in[i]
        u, v, q, k, val, g_a, g_b = jnp.split(proj, splits, axis=-1)
        y_a = gmlp_sgu(jax.nn.gelu(u), jax.nn.gelu(v), sgu_ln_g[i], sgu_ln_b[i], sgu_w[i], sgu_b[i])
        lam = (jnp.exp(jnp.sum(lam_q1[i].astype(jnp.float32) * lam_k1[i].astype(jnp.float32)))
               - jnp.exp(jnp.sum(lam_q2[i].astype(jnp.float32) * lam_k2[i].astype(jnp.float32)))
               + lam_init)
        o = diff_attention(q.reshape(B, S, N_HEADS, 2, HEAD_DIM),
                           k.reshape(B, S, N_HEADS, 2, HEAD_DIM),
                           val.reshape(B, S, N_HEADS, V_HEAD_DIM), lam, slopes)
        y_b = (head_rms_norm(o, attn_norm_g[i]) * (1.0 - lam_init)).reshape(B, S, ATTN_WIDTH)
        merged = jax.nn.sigmoid(g_a) * (y_a @ w_branch_a[i]) + jax.nn.sigmoid(g_b) * (y_b @ w_branch_b[i])
        x = layer_norm(ALPHA * x + merged @ w_out[i], ln2_g[i], ln2_b[i])
        x = layer_norm(ALPHA * x + 0.5 * swiglu(x, ffn2_w_gu[i], ffn2_w_down[i]), ln3_g[i], ln3_b[i])
        e = jax.nn.sigmoid(x @ w_pe_gate[i]) * (p[i] @ w_pe_proj[i])
        x = layer_norm(ALPHA * x + e, ln4_g[i], ln4_b[i])
    return x
```

```cpp
#include <hip/hip_runtime.h>
#include <hip/hip_cooperative_groups.h>
#include <cstdio>
#include <cstdint>
namespace cg = cooperative_groups;

#define LAS __attribute__((address_space(3)))
typedef unsigned short bf16_t;
typedef short bf16x8 __attribute__((ext_vector_type(8)));
typedef float f32x2 __attribute__((ext_vector_type(2)));
typedef float f32x4 __attribute__((ext_vector_type(4)));
typedef float f32x16 __attribute__((ext_vector_type(16)));
typedef unsigned u32x2 __attribute__((ext_vector_type(2)));
typedef unsigned u32x4 __attribute__((ext_vector_type(4)));
typedef __bf16 bf16x2_t __attribute__((ext_vector_type(2)));

constexpr int DM = 2048, SEQ = 4096, NB = 4, MROWS = NB * SEQ, DFF = 5632, PDIM = 256;
constexpr int PCOLS = 8192;
constexpr int PC_U = 0, PC_V = 1024, PC_Q = 2048, PC_K = 3072, PC_GA = 4096, PC_GB = 6144;
constexpr float LN_EPS = 1e-5f;
constexpr float ALPHA = 1.189207115002721f;
constexpr float QSCALE = 0.125f * 1.4426950408889634f;

constexpr size_t MiB = 1u << 20;
constexpr size_t WS_WGU = 1 * MiB;
constexpr size_t WS_WD = 45 * MiB;
constexpr size_t WS_WIN = 67 * MiB;
constexpr size_t WS_WA = 103 * MiB;
constexpr size_t WS_WB = 107 * MiB;
constexpr size_t WS_WOUT = 111 * MiB;
constexpr size_t WS_WG = 119 * MiB;
constexpr size_t WS_WP = 127 * MiB;
constexpr size_t WS_XB = 128 * MiB;
constexpr size_t WS_PB = 192 * MiB;
constexpr size_t WS_BIG = 200 * MiB;
constexpr size_t WS_PE = 376 * MiB;
constexpr size_t WS_VT = 456 * MiB;
constexpr size_t WS_END = 488 * MiB;

constexpr int LDS_BYTES = 147456;

__device__ __forceinline__ unsigned cvtpk(float lo, float hi) { f32x2 v = {lo, hi}; bf16x2_t b = __builtin_convertvector(v, bf16x2_t); return __builtin_bit_cast(unsigned, b); }
__device__ __forceinline__ float bflo(unsigned w) { return __uint_as_float(w << 16); }
__device__ __forceinline__ float bfhi(unsigned w) { return __uint_as_float(w & 0xffff0000u); }
__device__ __forceinline__ float sigm(float x) { return __builtin_amdgcn_rcpf(1.f + __builtin_amdgcn_exp2f(-1.4426950408889634f * x)); }
__device__ __forceinline__ float gelu_t(float x) { return x * sigm(1.5957691216057308f * (x + 0.044715f * x * x * x)); }
__device__ __forceinline__ float wave_sum(float v) {
#pragma unroll
    for (int o = 1; o < 64; o <<= 1) v += __shfl_xor(v, o);
    return v;
}
#define MFMA32(a, b, c) __builtin_amdgcn_mfma_f32_32x32x16_bf16((a), (b), (c), 0, 0, 0)

namespace pg8 {
constexpr int BM = 256, BK = 64, HALF = 128, HTB = HALF * BK * 2, STAGE_BYTES = 8 * HTB, NXCD = 8, WGM = 8;
__host__ __device__ __forceinline__ int lds_byte(int r, int c) { const int st = (r >> 4) * 2 + (c >> 5), rr = r & 15, cc = c & 31, ob = rr * 64 + cc * 2; return st * 1024 + (ob ^ (((ob >> 9) & 1) << 5)); }
__host__ __device__ __forceinline__ void stage_rc(int b, int& R, int& C) { const int st = b / 1024, sb = b % 1024, swz = sb ^ (((sb >> 9) & 1) << 5); R = (st >> 1) * 16 + swz / 64; C = (st & 1) * 32 + (swz % 64) / 2; }
__host__ __device__ __forceinline__ int perm32(int rho) { const int n = rho >> 4, i = rho & 15; return 8 * (i >> 2) + 4 * n + (i & 3); }

struct Unit { int pm, pn; };
struct Gemm { const bf16_t* A; const bf16_t* Bt; int M, N, K, lda, ldb; };

struct StaticOrder {
    int nM, nN, nwg, G, c;
    __device__ void init(int M, int N, int G_, int c_) { nM = M / BM; nN = N / BM; nwg = nM * nN; G = G_; c = c_; }
    __device__ bool next(int i, Unit& u) const {
        const long L = (long)i * G + c; if (L >= nwg) return false;
        int wgid = (int)L; { const int q = nwg / NXCD, r = nwg % NXCD, xcd = wgid % NXCD, off = wgid / NXCD; wgid = (xcd < r ? xcd * (q + 1) : r * (q + 1) + (xcd - r) * q) + off; }
        const int nig = WGM * nN, gid = wgid / nig, fm = gid * WGM, gsz = (nM - fm) < WGM ? (nM - fm) : WGM;
        u.pm = fm + ((wgid % nig) % gsz); u.pn = (wgid % nig) / gsz; return true;
    }
};

typedef f32x4 Acc[2][2][4][2];

struct EpiBf16 {
    static constexpr bool PERM = true;
    bf16_t* O; int ldc;
    __device__ __forceinline__ void operator()(const Acc& acc, const Unit& u, int wr, int wc, int fr, int fq) const {
        const int row0 = u.pm * BM + wr * 64 + fr, col0 = u.pn * BM + wc * 32 + 8 * fq;
#pragma unroll
        for (int ai = 0; ai < 2; ++ai)
#pragma unroll
            for (int m = 0; m < 4; ++m) { bf16_t* rowp = O + (size_t)(row0 + ai * HALF + m * 16) * ldc + col0;
#pragma unroll
                for (int bj = 0; bj < 2; ++bj) { const f32x4 v0 = acc[ai][bj][m][0], v1 = acc[ai][bj][m][1];
                    u32x4 w; w.x = cvtpk(v0[0], v0[1]); w.y = cvtpk(v0[2], v0[3]); w.z = cvtpk(v1[0], v1[1]); w.w = cvtpk(v1[2], v1[3]);
                    *(u32x4*)(rowp + bj * HALF) = w; } }
    }
};
struct EpiSwiGLU {
    static constexpr bool PERM = true;
    bf16_t* O; int ldc;
    __device__ __forceinline__ void operator()(const Acc& acc, const Unit& u, int wr, int wc, int fr, int fq) const {
        const int row0 = u.pm * BM + wr * 64 + fr, col0 = u.pn * HALF + wc * 32 + 8 * fq;
#pragma unroll
        for (int ai = 0; ai < 2; ++ai)
#pragma unroll
            for (int m = 0; m < 4; ++m) { bf16_t* rowp = O + (size_t)(row0 + ai * HALF + m * 16) * ldc + col0;
                float h[8];
#pragma unroll
                for (int n = 0; n < 2; ++n)
#pragma unroll
                    for (int j = 0; j < 4; ++j) { const float g = acc[ai][0][m][n][j], up = acc[ai][1][m][n][j]; h[n * 4 + j] = g * sigm(g) * up; }
                u32x4 w; w.x = cvtpk(h[0], h[1]); w.y = cvtpk(h[2], h[3]); w.z = cvtpk(h[4], h[5]); w.w = cvtpk(h[6], h[7]);
                *(u32x4*)rowp = w; }
    }
};
struct EpiProj {
    static constexpr bool PERM = true;
    bf16_t* O; int ldc;
    __device__ __forceinline__ void operator()(const Acc& acc, const Unit& u, int wr, int wc, int fr, int fq) const {
        const int row0 = u.pm * BM + wr * 64 + fr, col0 = u.pn * BM + wc * 32 + 8 * fq;
        const int mode = u.pn < 8 ? 0 : (u.pn < 12 ? 1 : (u.pn < 16 ? 2 : 3));
#pragma unroll
        for (int ai = 0; ai < 2; ++ai)
#pragma unroll
            for (int m = 0; m < 4; ++m) { bf16_t* rowp = O + (size_t)(row0 + ai * HALF + m * 16) * ldc + col0;
#pragma unroll
                for (int bj = 0; bj < 2; ++bj) { float h[8];
#pragma unroll
                    for (int n = 0; n < 2; ++n)
#pragma unroll
                        for (int j = 0; j < 4; ++j) { const float x = acc[ai][bj][m][n][j];
                            h[n * 4 + j] = mode == 0 ? gelu_t(x) : (mode == 1 ? x * QSCALE : (mode == 2 ? x : sigm(x))); }
                    u32x4 w; w.x = cvtpk(h[0], h[1]); w.y = cvtpk(h[2], h[3]); w.z = cvtpk(h[4], h[5]); w.w = cvtpk(h[6], h[7]);
                    *(u32x4*)(rowp + bj * HALF) = w; } }
    }
};
struct EpiGate {
    static constexpr bool PERM = true;
    const bf16_t* G; const bf16_t* T; bf16_t* O; int ld;
    __device__ __forceinline__ void operator()(const Acc& acc, const Unit& u, int wr, int wc, int fr, int fq) const {
        const int row0 = u.pm * BM + wr * 64 + fr, col0 = u.pn * BM + wc * 32 + 8 * fq;
#pragma unroll
        for (int ai = 0; ai < 2; ++ai)
#pragma unroll
            for (int m = 0; m < 4; ++m) { const size_t off = (size_t)(row0 + ai * HALF + m * 16) * ld + col0;
#pragma unroll
                for (int bj = 0; bj < 2; ++bj) { const u32x4 gw = *(const u32x4*)(G + off + bj * HALF);
                    u32x4 tw = (u32x4){0u, 0u, 0u, 0u}; if (T) tw = *(const u32x4*)(T + off + bj * HALF);
                    const f32x4 v0 = acc[ai][bj][m][0], v1 = acc[ai][bj][m][1];
                    u32x4 w;
                    w.x = cvtpk(bflo(tw.x) + bflo(gw.x) * v0[0], bfhi(tw.x) + bfhi(gw.x) * v0[1]);
                    w.y = cvtpk(bflo(tw.y) + bflo(gw.y) * v0[2], bfhi(tw.y) + bfhi(gw.y) * v0[3]);
                    w.z = cvtpk(bflo(tw.z) + bflo(gw.z) * v1[0], bfhi(tw.z) + bfhi(gw.z) * v1[1]);
                    w.w = cvtpk(bflo(tw.w) + bflo(gw.w) * v1[2], bfhi(tw.w) + bfhi(gw.w) * v1[3]);
                    *(u32x4*)(O + off + bj * HALF) = w; }
                asm volatile("" ::: "memory"); }
    }
};
template <int MODE> struct EpiRes {
    static constexpr bool PERM = false;
    const float* base; float* out; const bf16_t* PE; int ldc; float a, s;
    __device__ __forceinline__ void operator()(const Acc& acc, const Unit& u, int wr, int wc, int fr, int fq) const {
        const int row0 = u.pm * BM + wr * 64 + fr, col0 = u.pn * BM + wc * 32 + 4 * fq;
#pragma unroll
        for (int ai = 0; ai < 2; ++ai)
#pragma unroll
            for (int m = 0; m < 4; ++m) { const size_t off = (size_t)(row0 + ai * HALF + m * 16) * ldc + col0;
#pragma unroll
                for (int bj = 0; bj < 2; ++bj)
#pragma unroll
                    for (int n = 0; n < 2; ++n) { const size_t o2 = off + bj * HALF + n * 16; const f32x4 bs = *(const f32x4*)(base + o2); f32x4 v = acc[ai][bj][m][n];
                        if (MODE == 1) { const u32x2 pw = *(const u32x2*)(PE + o2);
                            v = (f32x4){sigm(v[0]) * bflo(pw.x), sigm(v[1]) * bfhi(pw.x), sigm(v[2]) * bflo(pw.y), sigm(v[3]) * bfhi(pw.y)}; }
                        *(f32x4*)(out + o2) = bs * a + v * s; }
                asm volatile("" ::: "memory"); }
    }
};

template <class Epi>
__device__ __forceinline__ void gemm_phase(LAS unsigned char* lds, const Gemm g, const StaticOrder& S, const Epi& E) {
    const int tid = threadIdx.x, wid = __builtin_amdgcn_readfirstlane(tid >> 6), lane = tid & 63, wr = wid >> 2, wc = wid & 3, fr = lane & 15, fq = lane >> 4;
    const int K = g.K, nt = K / BK;
    unsigned voffA[2], voffB[2];
#pragma unroll
    for (int i = 0; i < 2; ++i) { int R, C; stage_rc(tid * 16 + i * 8192, R, C); const int Rb = Epi::PERM ? ((R & ~31) + perm32(R & 31)) : R;
        voffA[i] = (unsigned)(R * g.lda + C) * 2u; voffB[i] = (unsigned)(Rb * g.ldb + C) * 2u; }
    const size_t kstep = (size_t)(BK * 2);
    const size_t hA = (size_t)HALF * g.lda * 2, hB = (size_t)HALF * g.ldb * 2;
    const size_t tA = 2 * hA, tB = 2 * hB;
    const unsigned ldsw = (unsigned)wid * 1024u;
    const int aoff = lds_byte(wr * 64 + fr, fq * 8), boff = lds_byte(wc * 32 + fr, fq * 8);
#define PG8_SA(b, h) (((b) * 2 + (h)) * HTB)
#define PG8_SB(b, h) ((4 + (b) * 2 + (h)) * HTB)
#define PG8_STAGE(bufoff, gbase, voff) do { _Pragma("unroll") for (int _i = 0; _i < 2; ++_i) \
        __builtin_amdgcn_global_load_lds((const unsigned*)((const char*)(gbase) + (voff)[_i]), (LAS unsigned*)(lds + (bufoff) + ldsw + _i * 8192), 16, 0, 0); } while (0)
#define PG8_LDA(dst, b, h) do { _Pragma("unroll") for (int m = 0; m < 4; ++m) _Pragma("unroll") for (int k = 0; k < 2; ++k) dst[m][k] = *(const LAS bf16x8*)(lds + PG8_SA(b, h) + aoff + m * 2048 + k * 1024); } while (0)
#define PG8_LDB(dst, b, h) do { _Pragma("unroll") for (int n = 0; n < 2; ++n) _Pragma("unroll") for (int k = 0; k < 2; ++k) dst[n][k] = *(const LAS bf16x8*)(lds + PG8_SB(b, h) + boff + n * 2048 + k * 1024); } while (0)
#define PG8_MMA(ai, bj, At, Bt) do { __builtin_amdgcn_s_setprio(1); _Pragma("unroll") for (int m = 0; m < 4; ++m) _Pragma("unroll") for (int n = 0; n < 2; ++n) _Pragma("unroll") for (int k = 0; k < 2; ++k) \
        acc[ai][bj][m][n] = __builtin_amdgcn_mfma_f32_16x16x32_bf16(Bt[n][k], At[m][k], acc[ai][bj][m][n], 0, 0, 0); __builtin_amdgcn_s_setprio(0); } while (0)
#define PG8_WAIT_V(n) asm volatile("s_waitcnt vmcnt(" #n ")" ::: "memory")
#define PG8_WAIT_L(n) asm volatile("s_waitcnt lgkmcnt(" #n ")" ::: "memory")
#define PG8_BAR __builtin_amdgcn_s_barrier()
#define PG8_SCHED __builtin_amdgcn_sched_barrier(0)
    Unit cur, nxt; int ui = 0;
    if (!S.next(0, cur)) return;
    Acc acc;
#pragma unroll
    for (int a = 0; a < 2; ++a)
#pragma unroll
        for (int b = 0; b < 2; ++b)
#pragma unroll
            for (int m = 0; m < 4; ++m)
#pragma unroll
                for (int n = 0; n < 2; ++n) acc[a][b][m][n] = (f32x4){0.f, 0.f, 0.f, 0.f};
    bf16x8 At[4][2], B0[2][2], B1[2][2];
    const char* cA = (const char*)g.A + (size_t)cur.pm * tA; const char* cB = (const char*)g.Bt + (size_t)cur.pn * tB;
    PG8_STAGE(PG8_SB(0, 0), cB, voffB); PG8_STAGE(PG8_SB(0, 1), cB + hB, voffB); PG8_STAGE(PG8_SA(0, 0), cA, voffA); PG8_STAGE(PG8_SA(0, 1), cA + hA, voffA);
    if (wr == 1) PG8_BAR;
    PG8_WAIT_V(2); PG8_BAR;
    PG8_STAGE(PG8_SB(1, 0), cB + kstep, voffB); PG8_STAGE(PG8_SA(1, 0), cA + kstep, voffA); PG8_STAGE(PG8_SB(1, 1), cB + hB + kstep, voffB);
    PG8_WAIT_V(6); PG8_BAR;
    for (;;) {
        const bool has_next = S.next(ui + 1, nxt);
        const char* nA = has_next ? (const char*)g.A + (size_t)nxt.pm * tA : cA; const char* nB = has_next ? (const char*)g.Bt + (size_t)nxt.pn * tB : cB;
        for (int t = 0; t < nt; t += 2) {
            const bool last = (t == nt - 2);
            const char* a1 = cA + (size_t)(t + 1) * kstep;
            const char* a2 = last ? nA : cA + (size_t)(t + 2) * kstep; const char* b2 = last ? nB : cB + (size_t)(t + 2) * kstep;
            const char* a3 = a2 + kstep; const char* b3 = b2 + kstep;
            PG8_LDB(B0, 0, 0); PG8_LDB(B1, 0, 1); PG8_SCHED; PG8_LDA(At, 0, 0); PG8_STAGE(PG8_SA(1, 1), a1 + hA, voffA);
            PG8_WAIT_V(8); PG8_WAIT_L(0); PG8_BAR; PG8_MMA(0, 0, At, B0); PG8_MMA(0, 1, At, B1); PG8_BAR; PG8_SCHED;
            PG8_LDA(At, 0, 1); PG8_STAGE(PG8_SB(0, 0), b2, voffB); PG8_STAGE(PG8_SB(0, 1), b2 + hB, voffB); PG8_STAGE(PG8_SA(0, 0), a2, voffA);
            PG8_WAIT_V(8); PG8_WAIT_L(0); PG8_BAR; PG8_MMA(1, 0, At, B0); PG8_MMA(1, 1, At, B1); PG8_BAR; PG8_SCHED;
            PG8_LDB(B0, 1, 0); PG8_LDB(B1, 1, 1); PG8_SCHED; PG8_LDA(At, 1, 0); PG8_STAGE(PG8_SA(0, 1), a2 + hA, voffA);
            PG8_WAIT_V(8); PG8_WAIT_L(0); PG8_BAR; PG8_MMA(0, 0, At, B0); PG8_MMA(0, 1, At, B1); PG8_BAR; PG8_SCHED;
            PG8_LDA(At, 1, 1); PG8_STAGE(PG8_SB(1, 0), b3, voffB); PG8_STAGE(PG8_SB(1, 1), b3 + hB, voffB); PG8_STAGE(PG8_SA(1, 0), a3, voffA);
            PG8_WAIT_V(8); PG8_WAIT_L(0); PG8_BAR; PG8_MMA(1, 0, At, B0); PG8_MMA(1, 1, At, B1); PG8_BAR; PG8_SCHED;
        }
        if (wr == 0) PG8_BAR;
        E(acc, cur, wr, wc, fr, fq);
        if (!has_next) break;
#pragma unroll
        for (int a = 0; a < 2; ++a)
#pragma unroll
            for (int b = 0; b < 2; ++b)
#pragma unroll
                for (int m = 0; m < 4; ++m)
#pragma unroll
                    for (int n = 0; n < 2; ++n) acc[a][b][m][n] = (f32x4){0.f, 0.f, 0.f, 0.f};
        cur = nxt; cA = nA; cB = nB; ++ui;
        if (wr == 1) PG8_BAR;
    }
    PG8_WAIT_V(0);
    PG8_BAR;
#undef PG8_SA
#undef PG8_SB
#undef PG8_STAGE
#undef PG8_LDA
#undef PG8_LDB
#undef PG8_MMA
#undef PG8_WAIT_V
#undef PG8_WAIT_L
#undef PG8_BAR
#undef PG8_SCHED
}
}

template <class Map>
__device__ __forceinline__ void transpose_w(const float* __restrict__ W, int K, int N, bf16_t* WT, Map map, LAS float* scr, int gw, int NGW, int lane) {
    const int nblk = N / 64, nitems = (K / 64) * nblk;
    for (int it = gw; it < nitems; it += NGW) {
        const int kb = it / nblk, nb = it % nblk, k0 = kb * 64, n0 = nb * 64;
        const int l16 = lane & 15, l4 = lane >> 4;
#pragma unroll 4
        for (int i = 0; i < 16; ++i) { const int kk = 4 * i + l4; const f32x4 v = *(const f32x4*)(W + (size_t)(k0 + kk) * N + n0 + 4 * l16);
            LAS float* d = scr + kk * 65 + 4 * l16; d[0] = v[0]; d[1] = v[1]; d[2] = v[2]; d[3] = v[3]; }
        asm volatile("s_waitcnt lgkmcnt(0)" ::: "memory");
        const int c = lane & 7; const int drow0 = map(n0);
#pragma unroll
        for (int j = 0; j < 8; ++j) { const int n = (lane >> 3) + 8 * j; const LAS float* s = scr + (8 * c) * 65 + n;
            u32x4 o; o.x = cvtpk(s[0], s[65]); o.y = cvtpk(s[2 * 65], s[3 * 65]); o.z = cvtpk(s[4 * 65], s[5 * 65]); o.w = cvtpk(s[6 * 65], s[7 * 65]);
            *(u32x4*)(WT + (size_t)(drow0 + n) * K + k0 + 8 * c) = o; }
        asm volatile("s_waitcnt lgkmcnt(0)" ::: "memory");
    }
}
struct MapId { __device__ __forceinline__ int operator()(int n0) const { return n0; } };
struct MapGU { __device__ __forceinline__ int operator()(int n0) const { const int bj = n0 / DFF, j = n0 % DFF; return (j / 128) * 256 + bj * 128 + (j % 128); } };
struct MapIn { __device__ __forceinline__ int operator()(int n0) const { return n0 < 4096 ? n0 : (n0 < 5120 ? n0 + 4096 : n0 - 1024); } };

__device__ __forceinline__ void cvt_flat(const float* __restrict__ src, bf16_t* dst, size_t n, int gt, int NGT) {
    for (size_t i = (size_t)gt * 8; i < n; i += (size_t)NGT * 8) { const f32x4 a = *(const f32x4*)(src + i), b = *(const f32x4*)(src + i + 4);
        u32x4 w; w.x = cvtpk(a[0], a[1]); w.y = cvtpk(a[2], a[3]); w.z = cvtpk(b[0], b[1]); w.w = cvtpk(b[2], b[3]); *(u32x4*)(dst + i) = w; }
}

template <bool WB> __device__ __forceinline__ void ln_row(float* row, const float* __restrict__ g, const float* __restrict__ b, bf16_t* xb, int lane) {
    f32x4* xr = (f32x4*)row + lane;
    f32x4 v[8]; float s = 0.f;
#pragma unroll
    for (int j = 0; j < 8; ++j) { v[j] = xr[64 * j]; s += (v[j][0] + v[j][1]) + (v[j][2] + v[j][3]); }
    const float mean = wave_sum(s) * (1.f / DM); float s2 = 0.f;
#pragma unroll
    for (int j = 0; j < 8; ++j) { v[j] = v[j] - mean; s2 += (v[j][0] * v[j][0] + v[j][1] * v[j][1]) + (v[j][2] * v[j][2] + v[j][3] * v[j][3]); }
    const float rstd = 1.f / sqrtf(wave_sum(s2) * (1.f / DM) + LN_EPS);
    u32x2* o8 = (u32x2*)xb + lane;
#pragma unroll
    for (int j = 0; j < 8; ++j) { const f32x4 gg = ((const f32x4*)g)[lane + 64 * j], bb = ((const f32x4*)b)[lane + 64 * j]; const f32x4 o = v[j] * rstd * gg + bb;
        xr[64 * j] = o; if (WB) { u32x2 w; w.x = cvtpk(o[0], o[1]); w.y = cvtpk(o[2], o[3]); o8[64 * j] = w; } }
}

namespace att {
constexpr int KPB = 272, VPB = 144;
constexpr int KBUF = 64 * KPB, VBUF = 128 * VPB, BUFB = KBUF + VBUF;

template <bool DIAG>
__device__ __forceinline__ void tile_step(const LAS unsigned char* kb, const LAS unsigned char* vb, const bf16x8 (&qf)[4], f32x16 (&O)[4], float& m_run, float& l_run,
                                          float sl2, int kv0, int qrow, int m, int r32, int hi) {
    f32x16 S0, S1;
    if (DIAG) { S0 = (f32x16){}; S1 = (f32x16){}; }
    else {
        const float b8 = sl2 * (float)(8 * hi);
#pragma unroll
        for (int r = 0; r < 16; ++r) { S0[r] = fmaf(sl2, (float)(16 * (r >> 3) + (r & 7)), b8); S1[r] = S0[r]; }
    }
    const int prow = (r32 & 19) | ((r32 & 4) << 1) | ((r32 & 8) >> 1);
    const LAS unsigned char* kp = kb + prow * KPB + (m * 64 + 8 * hi) * 2;
#pragma unroll
    for (int d0 = 0; d0 < 4; ++d0) { const bf16x8 k0 = *(const LAS bf16x8*)(kp + d0 * 32), k1 = *(const LAS bf16x8*)(kp + 32 * KPB + d0 * 32);
        S0 = MFMA32(k0, qf[d0], S0); S1 = MFMA32(k1, qf[d0], S1); }
    float ref0, ref1, mx, off;
    if (DIAG) {
        const float kbase = (float)(kv0 + 8 * hi - qrow);
#pragma unroll
        for (int r = 0; r < 16; ++r) { const float cr = (float)(16 * (r >> 3) + (r & 7)); S0[r] = fmaf(-fabsf(kbase + cr), sl2, S0[r]); S1[r] = fmaf(-fabsf(kbase + 32.f + cr), sl2, S1[r]); }
        mx = fmaxf(S0[0], S1[0]);
#pragma unroll
        for (int r = 1; r < 16; ++r) mx = fmaxf(mx, fmaxf(S0[r], S1[r]));
        off = sl2 * (float)qrow;
    } else {
        float m0 = S0[0], m1 = S1[0];
#pragma unroll
        for (int r = 1; r < 16; ++r) { m0 = fmaxf(m0, S0[r]); m1 = fmaxf(m1, S1[r]); }
        mx = fmaxf(m0, m1 + 32.f * sl2);
        off = sl2 * (float)kv0;
    }
    mx = fmaxf(mx, __shfl_xor(mx, 32));
    const float m_new = fmaxf(m_run, mx + off);
    ref0 = m_new - off; ref1 = DIAG ? ref0 : ref0 - 32.f * sl2;
    const float alpha = __builtin_amdgcn_exp2f(m_run - m_new); m_run = m_new;
    float ps = 0.f;
#pragma unroll
    for (int r = 0; r < 16; ++r) { S0[r] = __builtin_amdgcn_exp2f(S0[r] - ref0); S1[r] = __builtin_amdgcn_exp2f(S1[r] - ref1); ps += S0[r] + S1[r]; }
    l_run = l_run * alpha + ps;
    if (__any(alpha != 1.0f)) {
#pragma unroll
        for (int d = 0; d < 4; ++d)
#pragma unroll
            for (int r = 0; r < 16; ++r) O[d][r] *= alpha;
    }
    bf16x8 pf[4];
    { u32x4 p;
      p.x = cvtpk(S0[0], S0[1]); p.y = cvtpk(S0[2], S0[3]); p.z = cvtpk(S0[4], S0[5]); p.w = cvtpk(S0[6], S0[7]); pf[0] = __builtin_bit_cast(bf16x8, p);
      p.x = cvtpk(S0[8], S0[9]); p.y = cvtpk(S0[10], S0[11]); p.z = cvtpk(S0[12], S0[13]); p.w = cvtpk(S0[14], S0[15]); pf[1] = __builtin_bit_cast(bf16x8, p);
      p.x = cvtpk(S1[0], S1[1]); p.y = cvtpk(S1[2], S1[3]); p.z = cvtpk(S1[4], S1[5]); p.w = cvtpk(S1[6], S1[7]); pf[2] = __builtin_bit_cast(bf16x8, p);
      p.x = cvtpk(S1[8], S1[9]); p.y = cvtpk(S1[10], S1[11]); p.z = cvtpk(S1[12], S1[13]); p.w = cvtpk(S1[14], S1[15]); pf[3] = __builtin_bit_cast(bf16x8, p); }
    const LAS unsigned char* vp = vb + r32 * VPB + hi * 16;
#pragma unroll
    for (int d = 0; d < 4; ++d)
#pragma unroll
        for (int j = 0; j < 4; ++j) { const bf16x8 vf = *(const LAS bf16x8*)(vp + d * 32 * VPB + j * 32); O[d] = MFMA32(vf, pf[j], O[d]); }
}

__device__ __forceinline__ void attn_unit(LAS unsigned char* lds, bf16_t* PROJ, const bf16_t* __restrict__ VT, const float* __restrict__ gnorm, float lam,
                                          int b, int h, int qb, int tid, int wid, int lane) {
    const int r32 = lane & 31, hi = lane >> 5, m = wid & 1, qsub = wid >> 1;
    const int qrow = qb * 128 + qsub * 32 + r32;
    const int cq = 2 * qb + (qsub >> 1), NT = 2 * qb + 2;
    const float sl2 = __builtin_amdgcn_exp2f(-(float)(h + 1)) * 1.4426950408889634f;
    const size_t rowbase = (size_t)b * SEQ;
    bf16x8 qf[4];
    { const bf16_t* qp = PROJ + (rowbase + qrow) * PCOLS + PC_Q + h * 128 + m * 64 + 8 * hi;
#pragma unroll
      for (int d0 = 0; d0 < 4; ++d0) qf[d0] = *(const bf16x8*)(qp + 16 * d0); }
    const bf16_t* kg = PROJ + rowbase * PCOLS + PC_K + h * 128;
    const bf16_t* vg = VT + (size_t)(h * 128) * MROWS + rowbase;
    u32x4 pk0, pk1, pv0, pv1;
#define ATT_GLOAD(t) do { const int c0 = to_, c1 = to_ + 512; \
        pk0 = *(const u32x4*)(kg + (size_t)((t) * 64 + (c0 >> 4)) * PCOLS + (c0 & 15) * 8); pk1 = *(const u32x4*)(kg + (size_t)((t) * 64 + (c1 >> 4)) * PCOLS + (c1 & 15) * 8); \
        pv0 = *(const u32x4*)(vg + (size_t)(c0 >> 3) * MROWS + (t) * 64 + (c0 & 7) * 8); pv1 = *(const u32x4*)(vg + (size_t)(c1 >> 3) * MROWS + (t) * 64 + (c1 & 7) * 8); } while (0)
#define ATT_LSTORE(buf) do { const int c0 = to_, c1 = to_ + 512; LAS unsigned char* base_ = lds + (buf) * BUFB; \
        *(LAS u32x4*)(base_ + (c0 >> 4) * KPB + (c0 & 15) * 16) = pk0; *(LAS u32x4*)(base_ + (c1 >> 4) * KPB + (c1 & 15) * 16) = pk1; \
        *(LAS u32x4*)(base_ + KBUF + (c0 >> 3) * VPB + (c0 & 7) * 16) = pv0; *(LAS u32x4*)(base_ + KBUF + (c1 >> 3) * VPB + (c1 & 7) * 16) = pv1; } while (0)
    f32x16 O[4];
#pragma unroll
    for (int d = 0; d < 4; ++d) O[d] = (f32x16){};
    float m_run = -1e30f, l_run = 0.f;
    { int to_ = tid; asm volatile("" : "+v"(to_)); ATT_GLOAD(0); ATT_LSTORE(0); }
    __syncthreads();
#pragma unroll 1
    for (int t = 0; t < NT; ++t) {
        int to_ = tid, lo_ = lane; asm volatile("" : "+v"(to_), "+v"(lo_));
        const int r32o = lo_ & 31, hio = lo_ >> 5;
        if (t + 1 < NT) ATT_GLOAD(t + 1);
        const LAS unsigned char* kb = lds + (t & 1) * BUFB;
        if (t < cq) tile_step<false>(kb, kb + KBUF, qf, O, m_run, l_run, sl2, t * 64, qrow, m, r32o, hio);
        else if (t == cq) tile_step<true>(kb, kb + KBUF, qf, O, m_run, l_run, sl2, t * 64, qrow, m, r32o, hio);
        if (t + 1 < NT) ATT_LSTORE((t + 1) & 1);
        __syncthreads();
    }
#undef ATT_GLOAD
#undef ATT_LSTORE
    l_run += __shfl_xor(l_run, 32);
    const float inv = 1.f / l_run;
    LAS float* ex = (LAS float*)lds + qsub * 4096;
    if (m == 1) {
#pragma unroll
        for (int d = 0; d < 4; ++d)
#pragma unroll
            for (int r = 0; r < 16; ++r) ex[(d * 16 + r) * 64 + lane] = O[d][r] * inv;
    }
    __syncthreads();
    if (m == 0) {
        float ss = 0.f;
#pragma unroll
        for (int d = 0; d < 4; ++d)
#pragma unroll
            for (int r = 0; r < 16; ++r) { const float o = O[d][r] * inv - lam * ex[(d * 16 + r) * 64 + lane]; O[d][r] = o; ss += o * o; }
        ss += __shfl_xor(ss, 32);
        const float rs = 0.8f / sqrtf(ss * (1.f / 128.f) + LN_EPS);
        bf16_t* yp = PROJ + (rowbase + qrow) * PCOLS + PC_Q + h * 128 + 4 * hi;
        const float* gp = gnorm + h * 128 + 4 * hi;
#pragma unroll
        for (int d = 0; d < 4; ++d)
#pragma unroll
            for (int rq = 0; rq < 4; ++rq) { const int dd = d * 32 + 8 * rq; const f32x4 gv = *(const f32x4*)(gp + dd);
                u32x2 w; w.x = cvtpk(O[d][4 * rq] * rs * gv[0], O[d][4 * rq + 1] * rs * gv[1]); w.y = cvtpk(O[d][4 * rq + 2] * rs * gv[2], O[d][4 * rq + 3] * rs * gv[3]);
                *(u32x2*)(yp + dd) = w; }
    }
    __syncthreads();
}
}

__device__ __forceinline__ void sgu_unit(LAS unsigned char* lds, bf16_t* PROJ, const float* __restrict__ lng, const float* __restrict__ lnb, const float* __restrict__ sw, const float* __restrict__ sb,
                                         int nb, int gp, int tid, int wid, int lane) {
    constexpr int TP = 272;
    LAS f32x2* stat = (LAS f32x2*)(lds + 40960);
    const int r32 = lane & 31, hi = lane >> 5;
    for (int rr = 0; rr < 16; ++rr) {
        const int row = wid * 16 + rr; const bf16_t* vp = PROJ + (size_t)(nb * 128 + row) * PCOLS + PC_V + 8 * lane;
        const u32x4 a = *(const u32x4*)vp, c = *(const u32x4*)(vp + 512);
        float x[16] = {bflo(a.x), bfhi(a.x), bflo(a.y), bfhi(a.y), bflo(a.z), bfhi(a.z), bflo(a.w), bfhi(a.w), bflo(c.x), bfhi(c.x), bflo(c.y), bfhi(c.y), bflo(c.z), bfhi(c.z), bflo(c.w), bfhi(c.w)};
        float s = 0.f;
#pragma unroll
        for (int e = 0; e < 16; ++e) s += x[e];
        const float mean = wave_sum(s) * (1.f / 1024.f); float q = 0.f;
#pragma unroll
        for (int e = 0; e < 16; ++e) { const float d = x[e] - mean; q += d * d; }
        const float rstd = 1.f / sqrtf(wave_sum(q) * (1.f / 1024.f) + LN_EPS);
        if (lane == 0) stat[row] = (f32x2){mean, rstd};
    }
    __syncthreads();
    for (int gi = 0; gi < 2; ++gi) {
        const int g = 2 * gp + gi;
#pragma unroll
        for (int i = 0; i < 4; ++i) { const int c = tid + 512 * i, s = c >> 4, cc = c & 15;
            const u32x4 raw = *(const u32x4*)(PROJ + (size_t)(nb * 128 + s) * PCOLS + PC_V + g * 128 + 8 * cc);
            const f32x2 st = stat[s];
            const f32x4 g0 = *(const f32x4*)(lng + g * 128 + 8 * cc), g1 = *(const f32x4*)(lng + g * 128 + 8 * cc + 4), b0 = *(const f32x4*)(lnb + g * 128 + 8 * cc), b1 = *(const f32x4*)(lnb + g * 128 + 8 * cc + 4);
            float y[8] = {bflo(raw.x), bfhi(raw.x), bflo(raw.y), bfhi(raw.y), bflo(raw.z), bfhi(raw.z), bflo(raw.w), bfhi(raw.w)};
#pragma unroll
            for (int e = 0; e < 8; ++e) { const float gg = e < 4 ? g0[e & 3] : g1[e & 3], bb = e < 4 ? b0[e & 3] : b1[e & 3]; const float v = (y[e] - st[0]) * st[1] * gg + bb;
                *(LAS bf16_t*)(lds + (8 * cc + e) * TP + s * 2) = (bf16_t)(cvtpk(v, 0.f) & 0xffffu); } }
        __syncthreads();
        const int tblk = wid & 3, cb0 = (wid >> 2) * 2;
        f32x16 acc0 = (f32x16){}, acc1 = (f32x16){};
        const int nk = tblk < 2 ? 4 : 8;
        const float* wp = sw + (size_t)g * 16384 + (size_t)(tblk * 32 + r32) * 128 + 8 * hi;
        for (int k0 = 0; k0 < nk; ++k0) { const f32x4 w0 = *(const f32x4*)(wp + 16 * k0), w1 = *(const f32x4*)(wp + 16 * k0 + 4);
            u32x4 p; p.x = cvtpk(w0[0], w0[1]); p.y = cvtpk(w0[2], w0[3]); p.z = cvtpk(w1[0], w1[1]); p.w = cvtpk(w1[2], w1[3]); const bf16x8 wf = __builtin_bit_cast(bf16x8, p);
            const bf16x8 v0 = *(const LAS bf16x8*)(lds + (cb0 * 32 + r32) * TP + (16 * k0 + 8 * hi) * 2), v1 = *(const LAS bf16x8*)(lds + ((cb0 + 1) * 32 + r32) * TP + (16 * k0 + 8 * hi) * 2);
            acc0 = MFMA32(v0, wf, acc0); acc1 = MFMA32(v1, wf, acc1); }
        const int t = tblk * 32 + r32; const float bias = sb[g * 128 + t];
        bf16_t* up = PROJ + (size_t)(nb * 128 + t) * PCOLS + PC_U + g * 128 + 4 * hi;
#pragma unroll
        for (int cbi = 0; cbi < 2; ++cbi)
#pragma unroll
            for (int rq = 0; rq < 4; ++rq) { const int c = (cb0 + cbi) * 32 + 8 * rq; const u32x2 uu = *(const u32x2*)(up + c);
                const float a0 = cbi ? acc1[4 * rq] : acc0[4 * rq], a1 = cbi ? acc1[4 * rq + 1] : acc0[4 * rq + 1], a2 = cbi ? acc1[4 * rq + 2] : acc0[4 * rq + 2], a3 = cbi ? acc1[4 * rq + 3] : acc0[4 * rq + 3];
                u32x2 w; w.x = cvtpk(bflo(uu.x) * (a0 + bias), bfhi(uu.x) * (a1 + bias)); w.y = cvtpk(bflo(uu.y) * (a2 + bias), bfhi(uu.y) * (a3 + bias));
                *(u32x2*)(up + c) = w; }
        __syncthreads();
    }
}

struct Args { const float* in[29]; float* out; unsigned char* ws; int ph_lo, ph_hi; };
constexpr int NPHASE = 15;

__global__ void __launch_bounds__(512, 2) mega_fwd(Args args) {
    extern __shared__ __attribute__((aligned(16))) unsigned char lds_raw[];
    LAS unsigned char* lds = (LAS unsigned char*)lds_raw;
    cg::grid_group grid = cg::this_grid();
    const int tid = threadIdx.x, lane = tid & 63, wid = __builtin_amdgcn_readfirstlane(tid >> 6);
    const int G = gridDim.x, bx = blockIdx.x;
    const int gw = bx * 8 + wid, NGW = G * 8, gt = bx * 512 + tid, NGT = G * 512;
    unsigned char* ws = args.ws;
    const float* x_in = args.in[0];
    float* R = args.out;
    bf16_t* WGU = (bf16_t*)(ws + WS_WGU); bf16_t* WD = (bf16_t*)(ws + WS_WD); bf16_t* WIN = (bf16_t*)(ws + WS_WIN);
    bf16_t* WA = (bf16_t*)(ws + WS_WA); bf16_t* WB = (bf16_t*)(ws + WS_WB); bf16_t* WOUT = (bf16_t*)(ws + WS_WOUT); bf16_t* WG = (bf16_t*)(ws + WS_WG); bf16_t* WP = (bf16_t*)(ws + WS_WP);
    bf16_t* XB = (bf16_t*)(ws + WS_XB); bf16_t* PB = (bf16_t*)(ws + WS_PB);
    bf16_t* PROJ = (bf16_t*)(ws + WS_BIG); bf16_t* HB = (bf16_t*)(ws + WS_BIG); bf16_t* PE = (bf16_t*)(ws + WS_PE); bf16_t* VT = (bf16_t*)(ws + WS_VT);
    const int lo = args.ph_lo, hi = args.ph_hi;
#ifndef PHMASK
#define PHMASK 0x7fff
#endif
#define IN(k) (((PHMASK >> (k)) & 1) && lo <= (k) && (k) < hi)
#define SEAM(k) do { if (IN(k) && IN((k) + 1)) grid.sync(); } while (0)
    LAS float* scr = (LAS float*)(lds + wid * 16640);

    if (IN(0)) {
        transpose_w(args.in[2], DM, 2 * DFF, WGU, MapGU(), scr, gw, NGW, lane);
        transpose_w(args.in[3], DFF, DM, WD, MapId(), scr, (gw + 512) % NGW, NGW, lane);
        transpose_w(args.in[6], DM, 9216, WIN, MapIn(), scr, gw, NGW, lane);
        transpose_w(args.in[16], 1024, DM, WA, MapId(), scr, (gw + 1024) % NGW, NGW, lane);
        transpose_w(args.in[17], 1024, DM, WB, MapId(), scr, (gw + 1536) % NGW, NGW, lane);
        transpose_w(args.in[18], DM, DM, WOUT, MapId(), scr, gw, NGW, lane);
        transpose_w(args.in[25], DM, DM, WG, MapId(), scr, gw, NGW, lane);
        transpose_w(args.in[26], PDIM, DM, WP, MapId(), scr, (gw + 768) % NGW, NGW, lane);
        cvt_flat(x_in, XB, (size_t)MROWS * DM, gt, NGT);
        cvt_flat(args.in[1], PB, (size_t)MROWS * PDIM, gt, NGT);
    }
    SEAM(0);
    if (IN(1)) { pg8::Gemm g{XB, WGU, MROWS, 2 * DFF, DM, DM, DM}; pg8::StaticOrder S; S.init(MROWS, 2 * DFF, G, bx); pg8::EpiSwiGLU E{HB, DFF}; pg8::gemm_phase(lds, g, S, E); }
    SEAM(1);
    if (IN(2)) { pg8::Gemm g{HB, WD, MROWS, DM, DFF, DFF, DFF}; pg8::StaticOrder S; S.init(MROWS, DM, G, bx); pg8::EpiRes<0> E{x_in, R, nullptr, DM, ALPHA, 0.5f}; pg8::gemm_phase(lds, g, S, E); }
    SEAM(2);
    if (IN(3)) {
        for (int r = gw; r < MROWS; r += NGW) ln_row<true>(R + (size_t)r * DM, args.in[4], args.in[5], XB + (size_t)r * DM, lane);
        transpose_w(args.in[21], DM, 2 * DFF, WGU, MapGU(), scr, gw, NGW, lane);
        transpose_w(args.in[22], DFF, DM, WD, MapId(), scr, (gw + 512) % NGW, NGW, lane);
    }
    SEAM(3);
    if (IN(4)) {
        { pg8::Gemm g{XB, WIN, MROWS, PCOLS, DM, DM, DM}; pg8::StaticOrder S; S.init(MROWS, PCOLS, G, bx); pg8::EpiProj E{PROJ, PCOLS}; pg8::gemm_phase(lds, g, S, E); }
        { pg8::Gemm g{WIN + (size_t)8192 * DM, XB, 1024, MROWS, DM, DM, DM}; pg8::StaticOrder S; S.init(1024, MROWS, G, bx); pg8::EpiBf16 E{VT, MROWS}; pg8::gemm_phase(lds, g, S, E); }
    }
    SEAM(4);
    if (IN(5)) {
        float lam;
        { const float a = args.in[11][lane] * args.in[12][lane], c = args.in[13][lane] * args.in[14][lane];
          lam = __expf(wave_sum(a)) - __expf(wave_sum(c)) + 0.2f; }
#pragma unroll 1
        for (int it = 0; it < 4; ++it) { const int pid = bx + G * (it >> 1); if (pid >= 512) break; const int bh = pid >> 4, s = pid & 15;
            att::attn_unit(lds, PROJ, VT, args.in[15], lam, bh >> 3, bh & 7, (it & 1) ? s : 31 - s, tid, wid, lane); }
        for (int un = bx; un < 512; un += G) sgu_unit(lds, PROJ, args.in[7], args.in[8], args.in[9], args.in[10], un >> 2, un & 3, tid, wid, lane);
    }
    SEAM(5);
    if (IN(6)) { pg8::Gemm g{PROJ + PC_U, WA, MROWS, DM, 1024, PCOLS, 1024}; pg8::StaticOrder S; S.init(MROWS, DM, G, bx); pg8::EpiGate E{PROJ + PC_GA, nullptr, PROJ + PC_GA, PCOLS}; pg8::gemm_phase(lds, g, S, E); }
    SEAM(6);
    if (IN(7)) { pg8::Gemm g{PROJ + PC_Q, WB, MROWS, DM, 1024, PCOLS, 1024}; pg8::StaticOrder S; S.init(MROWS, DM, G, bx); pg8::EpiGate E{PROJ + PC_GB, PROJ + PC_GA, PROJ + PC_GA, PCOLS}; pg8::gemm_phase(lds, g, S, E); }
    SEAM(7);
    if (IN(8)) { pg8::Gemm g{PROJ + PC_GA, WOUT, MROWS, DM, DM, PCOLS, DM}; pg8::StaticOrder S; S.init(MROWS, DM, G, bx); pg8::EpiRes<0> E{R, R, nullptr, DM, ALPHA, 1.0f}; pg8::gemm_phase(lds, g, S, E); }
    SEAM(8);
    if (IN(9)) { for (int r = gw; r < MROWS; r += NGW) ln_row<true>(R + (size_t)r * DM, args.in[19], args.in[20], XB + (size_t)r * DM, lane); }
    SEAM(9);
    if (IN(10)) {
        { pg8::Gemm g{PB, WP, MROWS, DM, PDIM, PDIM, PDIM}; pg8::StaticOrder S; S.init(MROWS, DM, G, bx); pg8::EpiBf16 E{PE, DM}; pg8::gemm_phase(lds, g, S, E); }
        { pg8::Gemm g{XB, WGU, MROWS, 2 * DFF, DM, DM, DM}; pg8::StaticOrder S; S.init(MROWS, 2 * DFF, G, bx); pg8::EpiSwiGLU E{HB, DFF}; pg8::gemm_phase(lds, g, S, E); }
    }
    SEAM(10);
    if (IN(11)) { pg8::Gemm g{HB, WD, MROWS, DM, DFF, DFF, DFF}; pg8::StaticOrder S; S.init(MROWS, DM, G, bx); pg8::EpiRes<0> E{R, R, nullptr, DM, ALPHA, 0.5f}; pg8::gemm_phase(lds, g, S, E); }
    SEAM(11);
    if (IN(12)) { for (int r = gw; r < MROWS; r += NGW) ln_row<true>(R + (size_t)r * DM, args.in[23], args.in[24], XB + (size_t)r * DM, lane); }
    SEAM(12);
    if (IN(13)) { pg8::Gemm g{XB, WG, MROWS, DM, DM, DM, DM}; pg8::StaticOrder S; S.init(MROWS, DM, G, bx); pg8::EpiRes<1> E{R, R, PE, DM, ALPHA, 1.0f}; pg8::gemm_phase(lds, g, S, E); }
    SEAM(13);
    if (IN(14)) { for (int r = gw; r < MROWS; r += NGW) ln_row<false>(R + (size_t)r * DM, args.in[27], args.in[28], nullptr, lane); }
#undef IN
#undef SEAM
}

#ifndef MK_SPLIT
#define MK_SPLIT 0
#endif
extern "C" void kernel_launch(void* const* d_in, const int* in_sizes, int n_in, void* d_out, int out_size, void* d_ws, size_t ws_size, hipStream_t stream) {
    static int grid = 0;
    if (grid == 0) {
        if (n_in != 29 || out_size != MROWS * DM || ws_size < WS_END) { fprintf(stderr, "kernel_launch: unexpected shapes (n_in %d out %d ws %zu)\n", n_in, out_size, ws_size); grid = -1; return; }
        int dev = 0, cus = 0, per_cu = 0;
        hipGetDevice(&dev); hipDeviceGetAttribute(&cus, hipDeviceAttributeMultiprocessorCount, dev);
        if (hipFuncSetAttribute((const void*)mega_fwd, hipFuncAttributeMaxDynamicSharedMemorySize, LDS_BYTES) != hipSuccess) { fprintf(stderr, "kernel_launch: hipFuncSetAttribute failed\n"); grid = -1; return; }
        if (hipOccupancyMaxActiveBlocksPerMultiprocessor(&per_cu, (const void*)mega_fwd, 512, LDS_BYTES) != hipSuccess || per_cu < 1) { fprintf(stderr, "kernel_launch: occupancy query gave %d\n", per_cu); per_cu = 1; }
        (void)hipGetLastError();
        grid = cus * 1;
    }
    if (grid < 0) return;
    Args a{};
    for (int i = 0; i < 29; ++i) a.in[i] = (const float*)d_in[i];
    a.out = (float*)d_out; a.ws = (unsigned char*)d_ws;
#if MK_SPLIT
    for (int p = 0; p < NPHASE; ++p) { a.ph_lo = p; a.ph_hi = p + 1; hipLaunchKernelGGL(mega_fwd, dim3(grid), dim3(512), LDS_BYTES, stream, a); }
#else
    a.ph_lo = 0; a.ph_hi = NPHASE;
    void* kargs[] = {&a};
    hipError_t e = hipLaunchCooperativeKernel((const void*)mega_fwd, dim3(grid), dim3(512), kargs, LDS_BYTES, stream);
    if (e != hipSuccess) fprintf(stderr, "cooperative launch failed: %s (grid %d)\n", hipGetErrorString(e), grid);
#endif
}
```

```cpp
#include <hip/hip_runtime.h>
#include <hip/hip_cooperative_groups.h>
#include <cstdio>
#include <cstdint>
namespace cg = cooperative_groups;

#define LAS __attribute__((address_space(3)))
typedef unsigned short bf16_t;
typedef short bf16x8 __attribute__((ext_vector_type(8)));
typedef float f32x2 __attribute__((ext_vector_type(2)));
typedef float f32x4 __attribute__((ext_vector_type(4)));
typedef float f32x16 __attribute__((ext_vector_type(16)));
typedef unsigned u32x2 __attribute__((ext_vector_type(2)));
typedef unsigned u32x4 __attribute__((ext_vector_type(4)));
typedef __bf16 bf16x2_t __attribute__((ext_vector_type(2)));

constexpr int DM = 2048, SEQ = 4096, NB = 4, MROWS = NB * SEQ, DFF = 5632, PDIM = 256;
constexpr int PCOLS = 8192;
constexpr int PC_U = 0, PC_V = 1024, PC_Q = 2048, PC_K = 3072, PC_GA = 4096, PC_GB = 6144;
constexpr float LN_EPS = 1e-5f;
constexpr float ALPHA = 1.189207115002721f;
constexpr float QSCALE = 0.125f * 1.4426950408889634f;

constexpr size_t MiB = 1u << 20;
constexpr size_t WS_CTL = 0, CTL_ZERO_BYTES = 65536;
constexpr size_t WS_WGU = 1 * MiB;
constexpr size_t WS_WD = 45 * MiB;
constexpr size_t WS_WIN = 67 * MiB;
constexpr size_t WS_WA = 103 * MiB;
constexpr size_t WS_WB = 107 * MiB;
constexpr size_t WS_WOUT = 111 * MiB;
constexpr size_t WS_WG = 119 * MiB;
constexpr size_t WS_WP = 127 * MiB;
constexpr size_t WS_XB = 128 * MiB;
constexpr size_t WS_PB = 192 * MiB;
constexpr size_t WS_BIG = 200 * MiB;
constexpr size_t WS_PE = 376 * MiB;
constexpr size_t WS_VT = 456 * MiB;
constexpr size_t WS_END = 488 * MiB;

constexpr int LDS_BYTES = 147456;

__device__ __forceinline__ unsigned cvtpk(float lo, float hi) { f32x2 v = {lo, hi}; bf16x2_t b = __builtin_convertvector(v, bf16x2_t); return __builtin_bit_cast(unsigned, b); }
__device__ __forceinline__ float bflo(unsigned w) { return __uint_as_float(w << 16); }
__device__ __forceinline__ float bfhi(unsigned w) { return __uint_as_float(w & 0xffff0000u); }
__device__ __forceinline__ float sigm(float x) { return __builtin_amdgcn_rcpf(1.f + __builtin_amdgcn_exp2f(-1.4426950408889634f * x)); }
__device__ __forceinline__ float gelu_t(float x) { return x * sigm(1.5957691216057308f * (x + 0.044715f * x * x * x)); }
__device__ __forceinline__ float wave_sum(float v) {
#pragma unroll
    for (int o = 1; o < 64; o <<= 1) v += __shfl_xor(v, o);
    return v;
}
#define MFMA32(a, b, c) __builtin_amdgcn_mfma_f32_32x32x16_bf16((a), (b), (c), 0, 0, 0)

namespace pg8 {
constexpr int BM = 256, BK = 64, HALF = 128, HTB = HALF * BK * 2, STAGE_BYTES = 8 * HTB, NXCD = 8, WGM = 8;
__host__ __device__ __forceinline__ int lds_byte(int r, int c) { const int st = (r >> 4) * 2 + (c >> 5), rr = r & 15, cc = c & 31, ob = rr * 64 + cc * 2; return st * 1024 + (ob ^ (((ob >> 9) & 1) << 5)); }
__host__ __device__ __forceinline__ void stage_rc(int b, int& R, int& C) { const int st = b / 1024, sb = b % 1024, swz = sb ^ (((sb >> 9) & 1) << 5); R = (st >> 1) * 16 + swz / 64; C = (st & 1) * 32 + (swz % 64) / 2; }
__host__ __device__ __forceinline__ int perm32(int rho) { const int n = rho >> 4, i = rho & 15; return 8 * (i >> 2) + 4 * n + (i & 3); }

struct Unit { int pm, pn; };
struct Gemm { const bf16_t* A; const bf16_t* Bt; int M, N, K, lda, ldb; };

struct StaticOrder {
    int nM, nN, nwg, G, c;
    __device__ void init(int M, int N, int G_, int c_) { nM = M / BM; nN = N / BM; nwg = nM * nN; G = G_; c = c_; }
    __device__ bool next(int i, Unit& u) const {
        const long L = (long)i * G + c; if (L >= nwg) return false;
        int wgid = (int)L; { const int q = nwg / NXCD, r = nwg % NXCD, xcd = wgid % NXCD, off = wgid / NXCD; wgid = (xcd < r ? xcd * (q + 1) : r * (q + 1) + (xcd - r) * q) + off; }
        const int nig = WGM * nN, gid = wgid / nig, fm = gid * WGM, gsz = (nM - fm) < WGM ? (nM - fm) : WGM;
        u.pm = fm + ((wgid % nig) % gsz); u.pn = (wgid % nig) / gsz; return true;
    }
};

typedef f32x4 Acc[2][2][4][2];

struct EpiBf16 {
    static constexpr bool PERM = true;
    bf16_t* O; int ldc;
    __device__ __forceinline__ void operator()(const Acc& acc, const Unit& u, int wr, int wc, int fr, int fq) const {
        const int row0 = u.pm * BM + wr * 64 + fr, col0 = u.pn * BM + wc * 32 + 8 * fq;
#pragma unroll
        for (int ai = 0; ai < 2; ++ai)
#pragma unroll
            for (int m = 0; m < 4; ++m) { bf16_t* rowp = O + (size_t)(row0 + ai * HALF + m * 16) * ldc + col0;
#pragma unroll
                for (int bj = 0; bj < 2; ++bj) { const f32x4 v0 = acc[ai][bj][m][0], v1 = acc[ai][bj][m][1];
                    u32x4 w; w.x = cvtpk(v0[0], v0[1]); w.y = cvtpk(v0[2], v0[3]); w.z = cvtpk(v1[0], v1[1]); w.w = cvtpk(v1[2], v1[3]);
                    *(u32x4*)(rowp + bj * HALF) = w; } }
    }
};
struct EpiSwiGLU {
    static constexpr bool PERM = true;
    bf16_t* O; int ldc;
    __device__ __forceinline__ void operator()(const Acc& acc, const Unit& u, int wr, int wc, int fr, int fq) const {
        const int row0 = u.pm * BM + wr * 64 + fr, col0 = u.pn * HALF + wc * 32 + 8 * fq;
#pragma unroll
        for (int ai = 0; ai < 2; ++ai)
#pragma unroll
            for (int m = 0; m < 4; ++m) { bf16_t* rowp = O + (size_t)(row0 + ai * HALF + m * 16) * ldc + col0;
                float h[8];
#pragma unroll
                for (int n = 0; n < 2; ++n)
#pragma unroll
                    for (int j = 0; j < 4; ++j) { const float g = acc[ai][0][m][n][j], up = acc[ai][1][m][n][j]; h[n * 4 + j] = g * sigm(g) * up; }
                u32x4 w; w.x = cvtpk(h[0], h[1]); w.y = cvtpk(h[2], h[3]); w.z = cvtpk(h[4], h[5]); w.w = cvtpk(h[6], h[7]);
                *(u32x4*)rowp = w; }
    }
};
struct EpiProj {
    static constexpr bool PERM = true;
    bf16_t* O; int ldc;
    __device__ __forceinline__ void operator()(const Acc& acc, const Unit& u, int wr, int wc, int fr, int fq) const {
        const int row0 = u.pm * BM + wr * 64 + fr, col0 = u.pn * BM + wc * 32 + 8 * fq;
        const int mode = u.pn < 8 ? 0 : (u.pn < 12 ? 1 : (u.pn < 16 ? 2 : 3));
#pragma unroll
        for (int ai = 0; ai < 2; ++ai)
#pragma unroll
            for (int m = 0; m < 4; ++m) { bf16_t* rowp = O + (size_t)(row0 + ai * HALF + m * 16) * ldc + col0;
#pragma unroll
                for (int bj = 0; bj < 2; ++bj) { float h[8];
#pragma unroll
                    for (int n = 0; n < 2; ++n)
#pragma unroll
                        for (int j = 0; j < 4; ++j) { const float x = acc[ai][bj][m][n][j];
                            h[n * 4 + j] = mode == 0 ? gelu_t(x) : (mode == 1 ? x * QSCALE : (mode == 2 ? x : sigm(x))); }
                    u32x4 w; w.x = cvtpk(h[0], h[1]); w.y = cvtpk(h[2], h[3]); w.z = cvtpk(h[4], h[5]); w.w = cvtpk(h[6], h[7]);
                    *(u32x4*)(rowp + bj * HALF) = w; } }
    }
};
struct EpiGate {
    static constexpr bool PERM = true;
    const bf16_t* G; const bf16_t* T; bf16_t* O; int ld;
    __device__ __forceinline__ void operator()(const Acc& acc, const Unit& u, int wr, int wc, int fr, int fq) const {
        const int row0 = u.pm * BM + wr * 64 + fr, col0 = u.pn * BM + wc * 32 + 8 * fq;
#pragma unroll
        for (int ai = 0; ai < 2; ++ai)
#pragma unroll
            for (int m = 0; m < 4; ++m) { const size_t off = (size_t)(row0 + ai * HALF + m * 16) * ld + col0;
#pragma unroll
                for (int bj = 0; bj < 2; ++bj) { const u32x4 gw = *(const u32x4*)(G + off + bj * HALF);
                    u32x4 tw = (u32x4){0u, 0u, 0u, 0u}; if (T) tw = *(const u32x4*)(T + off + bj * HALF);
                    const f32x4 v0 = acc[ai][bj][m][0], v1 = acc[ai][bj][m][1];
                    u32x4 w;
                    w.x = cvtpk(bflo(tw.x) + bflo(gw.x) * v0[0], bfhi(tw.x) + bfhi(gw.x) * v0[1]);
                    w.y = cvtpk(bflo(tw.y) + bflo(gw.y) * v0[2], bfhi(tw.y) + bfhi(gw.y) * v0[3]);
                    w.z = cvtpk(bflo(tw.z) + bflo(gw.z) * v1[0], bfhi(tw.z) + bfhi(gw.z) * v1[1]);
                    w.w = cvtpk(bflo(tw.w) + bflo(gw.w) * v1[2], bfhi(tw.w) + bfhi(gw.w) * v1[3]);
                    *(u32x4*)(O + off + bj * HALF) = w; }
                asm volatile("" ::: "memory"); }
    }
};
template <int MODE> struct EpiRes {
    static constexpr bool PERM = false;
    const float* base; float* out; const bf16_t* PE; int ldc; float a, s;
    __device__ __forceinline__ void operator()(const Acc& acc, const Unit& u, int wr, int wc, int fr, int fq) const {
        const int row0 = u.pm * BM + wr * 64 + fr, col0 = u.pn * BM + wc * 32 + 4 * fq;
#pragma unroll
        for (int ai = 0; ai < 2; ++ai)
#pragma unroll
            for (int m = 0; m < 4; ++m) { const size_t off = (size_t)(row0 + ai * HALF + m * 16) * ldc + col0;
#pragma unroll
                for (int bj = 0; bj < 2; ++bj)
#pragma unroll
                    for (int n = 0; n < 2; ++n) { const size_t o2 = off + bj * HALF + n * 16; const f32x4 bs = *(const f32x4*)(base + o2); f32x4 v = acc[ai][bj][m][n];
                        if (MODE == 1) { const u32x2 pw = *(const u32x2*)(PE + o2);
                            v = (f32x4){sigm(v[0]) * bflo(pw.x), sigm(v[1]) * bfhi(pw.x), sigm(v[2]) * bflo(pw.y), sigm(v[3]) * bfhi(pw.y)}; }
                        *(f32x4*)(out + o2) = bs * a + v * s; }
                asm volatile("" ::: "memory"); }
    }
};

template <class Epi>
__device__ __forceinline__ void gemm_phase(LAS unsigned char* lds, const Gemm g, const StaticOrder& S, const Epi& E) {
    const int tid = threadIdx.x, wid = __builtin_amdgcn_readfirstlane(tid >> 6), lane = tid & 63, wr = wid >> 2, wc = wid & 3, fr = lane & 15, fq = lane >> 4;
    const int K = g.K, nt = K / BK;
    unsigned voffA[2], voffB[2];
#pragma unroll
    for (int i = 0; i < 2; ++i) { int R, C; stage_rc(tid * 16 + i * 8192, R, C); const int Rb = Epi::PERM ? ((R & ~31) + perm32(R & 31)) : R;
        voffA[i] = (unsigned)(R * g.lda + C) * 2u; voffB[i] = (unsigned)(Rb * g.ldb + C) * 2u; }
    const size_t kstep = (size_t)(BK * 2);
    const size_t hA = (size_t)HALF * g.lda * 2, hB = (size_t)HALF * g.ldb * 2;
    const size_t tA = 2 * hA, tB = 2 * hB;
    const unsigned ldsw = (unsigned)wid * 1024u;
    const int aoff = lds_byte(wr * 64 + fr, fq * 8), boff = lds_byte(wc * 32 + fr, fq * 8);
#define PG8_SA(b, h) (((b) * 2 + (h)) * HTB)
#define PG8_SB(b, h) ((4 + (b) * 2 + (h)) * HTB)
#define PG8_STAGE(bufoff, gbase, voff) do { _Pragma("unroll") for (int _i = 0; _i < 2; ++_i) \
        __builtin_amdgcn_global_load_lds((const unsigned*)((const char*)(gbase) + (voff)[_i]), (LAS unsigned*)(lds + (bufoff) + ldsw + _i * 8192), 16, 0, 0); } while (0)
#define PG8_LDA(dst, b, h) do { _Pragma("unroll") for (int m = 0; m < 4; ++m) _Pragma("unroll") for (int k = 0; k < 2; ++k) dst[m][k] = *(const LAS bf16x8*)(lds + PG8_SA(b, h) + aoff + m * 2048 + k * 1024); } while (0)
#define PG8_LDB(dst, b, h) do { _Pragma("unroll") for (int n = 0; n < 2; ++n) _Pragma("unroll") for (int k = 0; k < 2; ++k) dst[n][k] = *(const LAS bf16x8*)(lds + PG8_SB(b, h) + boff + n * 2048 + k * 1024); } while (0)
#define PG8_MMA(ai, bj, At, Bt) do { __builtin_amdgcn_s_setprio(1); _Pragma("unroll") for (int m = 0; m < 4; ++m) _Pragma("unroll") for (int n = 0; n < 2; ++n) _Pragma("unroll") for (int k = 0; k < 2; ++k) \
        acc[ai][bj][m][n] = __builtin_amdgcn_mfma_f32_16x16x32_bf16(Bt[n][k], At[m][k], acc[ai][bj][m][n], 0, 0, 0); __builtin_amdgcn_s_setprio(0); } while (0)
#define PG8_WAIT_V(n) asm volatile("s_waitcnt vmcnt(" #n ")" ::: "memory")
#define PG8_WAIT_L(n) asm volatile("s_waitcnt lgkmcnt(" #n ")" ::: "memory")
#define PG8_BAR __builtin_amdgcn_s_barrier()
#define PG8_SCHED __builtin_amdgcn_sched_barrier(0)
    Unit cur, nxt; int ui = 0;
    if (!S.next(0, cur)) return;
    Acc acc;
#pragma unroll
    for (int a = 0; a < 2; ++a)
#pragma unroll
        for (int b = 0; b < 2; ++b)
#pragma unroll
            for (int m = 0; m < 4; ++m)
#pragma unroll
                for (int n = 0; n < 2; ++n) acc[a][b][m][n] = (f32x4){0.f, 0.f, 0.f, 0.f};
    bf16x8 At[4][2], B0[2][2], B1[2][2];
    const char* cA = (const char*)g.A + (size_t)cur.pm * tA; const char* cB = (const char*)g.Bt + (size_t)cur.pn * tB;
    PG8_STAGE(PG8_SB(0, 0), cB, voffB); PG8_STAGE(PG8_SB(0, 1), cB + hB, voffB); PG8_STAGE(PG8_SA(0, 0), cA, voffA); PG8_STAGE(PG8_SA(0, 1), cA + hA, voffA);
    if (wr == 1) PG8_BAR;
    PG8_WAIT_V(2); PG8_BAR;
    PG8_STAGE(PG8_SB(1, 0), cB + kstep, voffB); PG8_STAGE(PG8_SA(1, 0), cA + kstep, voffA); PG8_STAGE(PG8_SB(1, 1), cB + hB + kstep, voffB);
    PG8_WAIT_V(6); PG8_BAR;
    for (;;) {
        const bool has_next = S.next(ui + 1, nxt);
        const char* nA = has_next ? (const char*)g.A + (size_t)nxt.pm * tA : cA; const char* nB = has_next ? (const char*)g.Bt + (size_t)nxt.pn * tB : cB;
        for (int t = 0; t < nt; t += 2) {
            const bool last = (t == nt - 2);
            const char* a1 = cA + (size_t)(t + 1) * kstep;
            const char* a2 = last ? nA : cA + (size_t)(t + 2) * kstep; const char* b2 = last ? nB : cB + (size_t)(t + 2) * kstep;
            const char* a3 = a2 + kstep; const char* b3 = b2 + kstep;
            PG8_LDB(B0, 0, 0); PG8_LDB(B1, 0, 1); PG8_SCHED; PG8_LDA(At, 0, 0); PG8_STAGE(PG8_SA(1, 1), a1 + hA, voffA);
            PG8_WAIT_V(8); PG8_WAIT_L(0); PG8_BAR; PG8_MMA(0, 0, At, B0); PG8_MMA(0, 1, At, B1); PG8_BAR; PG8_SCHED;
            PG8_LDA(At, 0, 1); PG8_STAGE(PG8_SB(0, 0), b2, voffB); PG8_STAGE(PG8_SB(0, 1), b2 + hB, voffB); PG8_STAGE(PG8_SA(0, 0), a2, voffA);
            PG8_WAIT_V(8); PG8_WAIT_L(0); PG8_BAR; PG8_MMA(1, 0, At, B0); PG8_MMA(1, 1, At, B1); PG8_BAR; PG8_SCHED;
            PG8_LDB(B0, 1, 0); PG8_LDB(B1, 1, 1); PG8_SCHED; PG8_LDA(At, 1, 0); PG8_STAGE(PG8_SA(0, 1), a2 + hA, voffA);
            PG8_WAIT_V(8); PG8_WAIT_L(0); PG8_BAR; PG8_MMA(0, 0, At, B0); PG8_MMA(0, 1, At, B1); PG8_BAR; PG8_SCHED;
            PG8_LDA(At, 1, 1); PG8_STAGE(PG8_SB(1, 0), b3, voffB); PG8_STAGE(PG8_SB(1, 1), b3 + hB, voffB); PG8_STAGE(PG8_SA(1, 0), a3, voffA);
            PG8_WAIT_V(8); PG8_WAIT_L(0); PG8_BAR; PG8_MMA(1, 0, At, B0); PG8_MMA(1, 1, At, B1); PG8_BAR; PG8_SCHED;
        }
        if (wr == 0) PG8_BAR;
        E(acc, cur, wr, wc, fr, fq);
        if (!has_next) break;
#pragma unroll
        for (int a = 0; a < 2; ++a)
#pragma unroll
            for (int b = 0; b < 2; ++b)
#pragma unroll
                for (int m = 0; m < 4; ++m)
#pragma unroll
                    for (int n = 0; n < 2; ++n) acc[a][b][m][n] = (f32x4){0.f, 0.f, 0.f, 0.f};
        cur = nxt; cA = nA; cB = nB; ++ui;
        if (wr == 1) PG8_BAR;
    }
    PG8_WAIT_V(0);
    PG8_BAR;
#undef PG8_SA
#undef PG8_SB
#undef PG8_STAGE
#undef PG8_LDA
#undef PG8_LDB
#undef PG8_MMA
#undef PG8_WAIT_V
#undef PG8_WAIT_L
#undef PG8_BAR
#undef PG8_SCHED
}
}

template <class Map>
__device__ __forceinline__ void transpose_w(const float* __restrict__ W, int K, int N, bf16_t* WT, Map map, LAS float* scr, int gw, int NGW, int lane) {
    const int nblk = N / 64, nitems = (K / 64) * nblk;
    for (int it = gw; it < nitems; it += NGW) {
        const int kb = it / nblk, nb = it % nblk, k0 = kb * 64, n0 = nb * 64;
        const int l16 = lane & 15, l4 = lane >> 4;
#pragma unroll 4
        for (int i = 0; i < 16; ++i) { const int kk = 4 * i + l4; const f32x4 v = *(const f32x4*)(W + (size_t)(k0 + kk) * N + n0 + 4 * l16);
            LAS float* d = scr + kk * 65 + 4 * l16; d[0] = v[0]; d[1] = v[1]; d[2] = v[2]; d[3] = v[3]; }
        asm volatile("s_waitcnt lgkmcnt(0)" ::: "memory");
        const int c = lane & 7; const int drow0 = map(n0);
#pragma unroll
        for (int j = 0; j < 8; ++j) { const int n = (lane >> 3) + 8 * j; const LAS float* s = scr + (8 * c) * 65 + n;
            u32x4 o; o.x = cvtpk(s[0], s[65]); o.y = cvtpk(s[2 * 65], s[3 * 65]); o.z = cvtpk(s[4 * 65], s[5 * 65]); o.w = cvtpk(s[6 * 65], s[7 * 65]);
            *(u32x4*)(WT + (size_t)(drow0 + n) * K + k0 + 8 * c) = o; }
        asm volatile("s_waitcnt lgkmcnt(0)" ::: "memory");
    }
}
struct MapId { __device__ __forceinline__ int operator()(int n0) const { return n0; } };
struct MapGU { __device__ __forceinline__ int operator()(int n0) const { const int bj = n0 / DFF, j = n0 % DFF; return (j / 128) * 256 + bj * 128 + (j % 128); } };
struct MapIn { __device__ __forceinline__ int operator()(int n0) const { return n0 < 4096 ? n0 : (n0 < 5120 ? n0 + 4096 : n0 - 1024); } };

__device__ __forceinline__ void cvt_flat(const float* __restrict__ src, bf16_t* dst, size_t n, int gt, int NGT) {
    for (size_t i = (size_t)gt * 8; i < n; i += (size_t)NGT * 8) { const f32x4 a = *(const f32x4*)(src + i), b = *(const f32x4*)(src + i + 4);
        u32x4 w; w.x = cvtpk(a[0], a[1]); w.y = cvtpk(a[2], a[3]); w.z = cvtpk(b[0], b[1]); w.w = cvtpk(b[2], b[3]); *(u32x4*)(dst + i) = w; }
}

template <bool WB> __device__ __forceinline__ void ln_row(float* row, const float* __restrict__ g, const float* __restrict__ b, bf16_t* xb, int lane) {
    f32x4* xr = (f32x4*)row + lane;
    f32x4 v[8]; float s = 0.f;
#pragma unroll
    for (int j = 0; j < 8; ++j) { v[j] = xr[64 * j]; s += (v[j][0] + v[j][1]) + (v[j][2] + v[j][3]); }
    const float mean = wave_sum(s) * (1.f / DM); float s2 = 0.f;
#pragma unroll
    for (int j = 0; j < 8; ++j) { v[j] = v[j] - mean; s2 += (v[j][0] * v[j][0] + v[j][1] * v[j][1]) + (v[j][2] * v[j][2] + v[j][3] * v[j][3]); }
    const float rstd = 1.f / sqrtf(wave_sum(s2) * (1.f / DM) + LN_EPS);
    u32x2* o8 = (u32x2*)xb + lane;
#pragma unroll
    for (int j = 0; j < 8; ++j) { const f32x4 gg = ((const f32x4*)g)[lane + 64 * j], bb = ((const f32x4*)b)[lane + 64 * j]; const f32x4 o = v[j] * rstd * gg + bb;
        xr[64 * j] = o; if (WB) { u32x2 w; w.x = cvtpk(o[0], o[1]); w.y = cvtpk(o[2], o[3]); o8[64 * j] = w; } }
}

namespace att {
constexpr int KPB = 272, VPB = 144;
constexpr int KBUF = 64 * KPB, VBUF = 128 * VPB, BUFB = KBUF + VBUF;

template <bool DIAG>
__device__ __forceinline__ void tile_step(const LAS unsigned char* kb, const LAS unsigned char* vb, const bf16x8 (&qf)[4], f32x16 (&O)[4], float& m_run, float& l_run,
                                          float sl2, int kv0, int qrow, int m, int r32, int hi) {
    f32x16 S0, S1;
    if (DIAG) { S0 = (f32x16){}; S1 = (f32x16){}; }
    else {
        const float b8 = sl2 * (float)(8 * hi);
#pragma unroll
        for (int r = 0; r < 16; ++r) { S0[r] = fmaf(sl2, (float)(16 * (r >> 3) + (r & 7)), b8); S1[r] = S0[r]; }
    }
    const int prow = (r32 & 19) | ((r32 & 4) << 1) | ((r32 & 8) >> 1);
    const LAS unsigned char* kp = kb + prow * KPB + (m * 64 + 8 * hi) * 2;
#pragma unroll
    for (int d0 = 0; d0 < 4; ++d0) { const bf16x8 k0 = *(const LAS bf16x8*)(kp + d0 * 32), k1 = *(const LAS bf16x8*)(kp + 32 * KPB + d0 * 32);
        S0 = MFMA32(k0, qf[d0], S0); S1 = MFMA32(k1, qf[d0], S1); }
    float ref0, ref1, mx, off;
    if (DIAG) {
        const float kbase = (float)(kv0 + 8 * hi - qrow);
#pragma unroll
        for (int r = 0; r < 16; ++r) { const float cr = (float)(16 * (r >> 3) + (r & 7)); S0[r] = fmaf(-fabsf(kbase + cr), sl2, S0[r]); S1[r] = fmaf(-fabsf(kbase + 32.f + cr), sl2, S1[r]); }
        mx = fmaxf(S0[0], S1[0]);
#pragma unroll
        for (int r = 1; r < 16; ++r) mx = fmaxf(mx, fmaxf(S0[r], S1[r]));
        off = sl2 * (float)qrow;
    } else {
        float m0 = S0[0], m1 = S1[0];
#pragma unroll
        for (int r = 1; r < 16; ++r) { m0 = fmaxf(m0, S0[r]); m1 = fmaxf(m1, S1[r]); }
        mx = fmaxf(m0, m1 + 32.f * sl2);
        off = sl2 * (float)kv0;
    }
    mx = fmaxf(mx, __shfl_xor(mx, 32));
    const float m_new = fmaxf(m_run, mx + off);
    ref0 = m_new - off; ref1 = DIAG ? ref0 : ref0 - 32.f * sl2;
    const float alpha = __builtin_amdgcn_exp2f(m_run - m_new); m_run = m_new;
    float ps = 0.f;
#pragma unroll
    for (int r = 0; r < 16; ++r) { S0[r] = __builtin_amdgcn_exp2f(S0[r] - ref0); S1[r] = __builtin_amdgcn_exp2f(S1[r] - ref1); ps += S0[r] + S1[r]; }
    l_run = l_run * alpha + ps;
    if (__any(alpha != 1.0f)) {
#pragma unroll
        for (int d = 0; d < 4; ++d)
#pragma unroll
            for (int r = 0; r < 16; ++r) O[d][r] *= alpha;
    }
    bf16x8 pf[4];
    { u32x4 p;
      p.x = cvtpk(S0[0], S0[1]); p.y = cvtpk(S0[2], S0[3]); p.z = cvtpk(S0[4], S0[5]); p.w = cvtpk(S0[6], S0[7]); pf[0] = __builtin_bit_cast(bf16x8, p);
      p.x = cvtpk(S0[8], S0[9]); p.y = cvtpk(S0[10], S0[11]); p.z = cvtpk(S0[12], S0[13]); p.w = cvtpk(S0[14], S0[15]); pf[1] = __builtin_bit_cast(bf16x8, p);
      p.x = cvtpk(S1[0], S1[1]); p.y = cvtpk(S1[2], S1[3]); p.z = cvtpk(S1[4], S1[5]); p.w = cvtpk(S1[6], S1[7]); pf[2] = __builtin_bit_cast(bf16x8, p);
      p.x = cvtpk(S1[8], S1[9]); p.y = cvtpk(S1[10], S1[11]); p.z = cvtpk(S1[12], S1[13]); p.w = cvtpk(S1[14], S1[15]); pf[3] = __builtin_bit_cast(bf16x8, p); }
    const LAS unsigned char* vp = vb + r32 * VPB + hi * 16;
#pragma unroll
    for (int d = 0; d < 4; ++d)
#pragma unroll
        for (int j = 0; j < 4; ++j) { const bf16x8 vf = *(const LAS bf16x8*)(vp + d * 32 * VPB + j * 32); O[d] = MFMA32(vf, pf[j], O[d]); }
}

__device__ __forceinline__ void attn_unit(LAS unsigned char* lds, bf16_t* PROJ, const bf16_t* __restrict__ VT, const float* __restrict__ gnorm, float lam,
                                          int b, int h, int qb, int tid, int wid, int lane) {
    const int r32 = lane & 31, hi = lane >> 5, m = wid & 1, qsub = wid >> 1;
    const int qrow = qb * 128 + qsub * 32 + r32;
    const int cq = 2 * qb + (qsub >> 1), NT = 2 * qb + 2;
    const float sl2 = __builtin_amdgcn_exp2f(-(float)(h + 1)) * 1.4426950408889634f;
    const size_t rowbase = (size_t)b * SEQ;
    bf16x8 qf[4];
    { const bf16_t* qp = PROJ + (rowbase + qrow) * PCOLS + PC_Q + h * 128 + m * 64 + 8 * hi;
#pragma unroll
      for (int d0 = 0; d0 < 4; ++d0) qf[d0] = *(const bf16x8*)(qp + 16 * d0); }
    const bf16_t* kg = PROJ + rowbase * PCOLS + PC_K + h * 128;
    const bf16_t* vg = VT + (size_t)(h * 128) * MROWS + rowbase;
    u32x4 pk0, pk1, pv0, pv1;
#define ATT_GLOAD(t) do { const int c0 = to_, c1 = to_ + 512; \
        pk0 = *(const u32x4*)(kg + (size_t)((t) * 64 + (c0 >> 4)) * PCOLS + (c0 & 15) * 8); pk1 = *(const u32x4*)(kg + (size_t)((t) * 64 + (c1 >> 4)) * PCOLS + (c1 & 15) * 8); \
        pv0 = *(const u32x4*)(vg + (size_t)(c0 >> 3) * MROWS + (t) * 64 + (c0 & 7) * 8); pv1 = *(const u32x4*)(vg + (size_t)(c1 >> 3) * MROWS + (t) * 64 + (c1 & 7) * 8); } while (0)
#define ATT_LSTORE(buf) do { const int c0 = to_, c1 = to_ + 512; LAS unsigned char* base_ = lds + (buf) * BUFB; \
        *(LAS u32x4*)(base_ + (c0 >> 4) * KPB + (c0 & 15) * 16) = pk0; *(LAS u32x4*)(base_ + (c1 >> 4) * KPB + (c1 & 15) * 16) = pk1; \
        *(LAS u32x4*)(base_ + KBUF + (c0 >> 3) * VPB + (c0 & 7) * 16) = pv0; *(LAS u32x4*)(base_ + KBUF + (c1 >> 3) * VPB + (c1 & 7) * 16) = pv1; } while (0)
    f32x16 O[4];
#pragma unroll
    for (int d = 0; d < 4; ++d) O[d] = (f32x16){};
    float m_run = -1e30f, l_run = 0.f;
    { int to_ = tid; asm volatile("" : "+v"(to_)); ATT_GLOAD(0); ATT_LSTORE(0); }
    __syncthreads();
#pragma unroll 1
    for (int t = 0; t < NT; ++t) {
        int to_ = tid, lo_ = lane; asm volatile("" : "+v"(to_), "+v"(lo_));
        const int r32o = lo_ & 31, hio = lo_ >> 5;
        if (t + 1 < NT) ATT_GLOAD(t + 1);
        const LAS unsigned char* kb = lds + (t & 1) * BUFB;
        if (t < cq) tile_step<false>(kb, kb + KBUF, qf, O, m_run, l_run, sl2, t * 64, qrow, m, r32o, hio);
        else if (t == cq) tile_step<true>(kb, kb + KBUF, qf, O, m_run, l_run, sl2, t * 64, qrow, m, r32o, hio);
        if (t + 1 < NT) ATT_LSTORE((t + 1) & 1);
        __syncthreads();
    }
#undef ATT_GLOAD
#undef ATT_LSTORE
    l_run += __shfl_xor(l_run, 32);
    const float inv = 1.f / l_run;
    LAS float* ex = (LAS float*)lds + qsub * 4096;
    if (m == 1) {
#pragma unroll
        for (int d = 0; d < 4; ++d)
#pragma unroll
            for (int r = 0; r < 16; ++r) ex[(d * 16 + r) * 64 + lane] = O[d][r] * inv;
    }
    __syncthreads();
    if (m == 0) {
        float ss = 0.f;
#pragma unroll
        for (int d = 0; d < 4; ++d)
#pragma unroll
            for (int r = 0; r < 16; ++r) { const float o = O[d][r] * inv - lam * ex[(d * 16 + r) * 64 + lane]; O[d][r] = o; ss += o * o; }
        ss += __shfl_xor(ss, 32);
        const float rs = 0.8f / sqrtf(ss * (1.f / 128.f) + LN_EPS);
        bf16_t* yp = PROJ + (rowbase + qrow) * PCOLS + PC_Q + h * 128 + 4 * hi;
        const float* gp = gnorm + h * 128 + 4 * hi;
#pragma unroll
        for (int d = 0; d < 4; ++d)
#pragma unroll
            for (int rq = 0; rq < 4; ++rq) { const int dd = d * 32 + 8 * rq; const f32x4 gv = *(const f32x4*)(gp + dd);
                u32x2 w; w.x = cvtpk(O[d][4 * rq] * rs * gv[0], O[d][4 * rq + 1] * rs * gv[1]); w.y = cvtpk(O[d][4 * rq + 2] * rs * gv[2], O[d][4 * rq + 3] * rs * gv[3]);
                *(u32x2*)(yp + dd) = w; }
    }
    __syncthreads();
}
}

__device__ __forceinline__ void sgu_unit(LAS unsigned char* lds, bf16_t* PROJ, const float* __restrict__ lng, const float* __restrict__ lnb, const float* __restrict__ sw, const float* __restrict__ sb,
                                         int nb, int gp, int tid, int wid, int lane) {
    constexpr int TP = 272;
    LAS f32x2* stat = (LAS f32x2*)(lds + 40960);
    const int r32 = lane & 31, hi = lane >> 5;
    for (int rr = 0; rr < 16; ++rr) {
        const int row = wid * 16 + rr; const bf16_t* vp = PROJ + (size_t)(nb * 128 + row) * PCOLS + PC_V + 8 * lane;
        const u32x4 a = *(const u32x4*)vp, c = *(const u32x4*)(vp + 512);
        float x[16] = {bflo(a.x), bfhi(a.x), bflo(a.y), bfhi(a.y), bflo(a.z), bfhi(a.z), bflo(a.w), bfhi(a.w), bflo(c.x), bfhi(c.x), bflo(c.y), bfhi(c.y), bflo(c.z), bfhi(c.z), bflo(c.w), bfhi(c.w)};
        float s = 0.f;
#pragma unroll
        for (int e = 0; e < 16; ++e) s += x[e];
        const float mean = wave_sum(s) * (1.f / 1024.f); float q = 0.f;
#pragma unroll
        for (int e = 0; e < 16; ++e) { const float d = x[e] - mean; q += d * d; }
        const float rstd = 1.f / sqrtf(wave_sum(q) * (1.f / 1024.f) + LN_EPS);
        if (lane == 0) stat[row] = (f32x2){mean, rstd};
    }
    __syncthreads();
    for (int gi = 0; gi < 2; ++gi) {
        const int g = 2 * gp + gi;
#pragma unroll
        for (int i = 0; i < 4; ++i) { const int c = tid + 512 * i, s = c >> 4, cc = c & 15;
            const u32x4 raw = *(const u32x4*)(PROJ + (size_t)(nb * 128 + s) * PCOLS + PC_V + g * 128 + 8 * cc);
            const f32x2 st = stat[s];
            const f32x4 g0 = *(const f32x4*)(lng + g * 128 + 8 * cc), g1 = *(const f32x4*)(lng + g * 128 + 8 * cc + 4), b0 = *(const f32x4*)(lnb + g * 128 + 8 * cc), b1 = *(const f32x4*)(lnb + g * 128 + 8 * cc + 4);
            float y[8] = {bflo(raw.x), bfhi(raw.x), bflo(raw.y), bfhi(raw.y), bflo(raw.z), bfhi(raw.z), bflo(raw.w), bfhi(raw.w)};
#pragma unroll
            for (int e = 0; e < 8; ++e) { const float gg = e < 4 ? g0[e & 3] : g1[e & 3], bb = e < 4 ? b0[e & 3] : b1[e & 3]; const float v = (y[e] - st[0]) * st[1] * gg + bb;
                *(LAS bf16_t*)(lds + (8 * cc + e) * TP + s * 2) = (bf16_t)(cvtpk(v, 0.f) & 0xffffu); } }
        __syncthreads();
        const int tblk = wid & 3, cb0 = (wid >> 2) * 2;
        f32x16 acc0 = (f32x16){}, acc1 = (f32x16){};
        const int nk = tblk < 2 ? 4 : 8;
        const float* wp = sw + (size_t)g * 16384 + (size_t)(tblk * 32 + r32) * 128 + 8 * hi;
        for (int k0 = 0; k0 < nk; ++k0) { const f32x4 w0 = *(const f32x4*)(wp + 16 * k0), w1 = *(const f32x4*)(wp + 16 * k0 + 4);
            u32x4 p; p.x = cvtpk(w0[0], w0[1]); p.y = cvtpk(w0[2], w0[3]); p.z = cvtpk(w1[0], w1[1]); p.w = cvtpk(w1[2], w1[3]); const bf16x8 wf = __builtin_bit_cast(bf16x8, p);
            const bf16x8 v0 = *(const LAS bf16x8*)(lds + (cb0 * 32 + r32) * TP + (16 * k0 + 8 * hi) * 2), v1 = *(const LAS bf16x8*)(lds + ((cb0 + 1) * 32 + r32) * TP + (16 * k0 + 8 * hi) * 2);
            acc0 = MFMA32(v0, wf, acc0); acc1 = MFMA32(v1, wf, acc1); }
        const int t = tblk * 32 + r32; const float bias = sb[g * 128 + t];
        bf16_t* up = PROJ + (size_t)(nb * 128 + t) * PCOLS + PC_U + g * 128 + 4 * hi;
#pragma unroll
        for (int cbi = 0; cbi < 2; ++cbi)
#pragma unroll
            for (int rq = 0; rq < 4; ++rq) { const int c = (cb0 + cbi) * 32 + 8 * rq; const u32x2 uu = *(const u32x2*)(up + c);
                const float a0 = cbi ? acc1[4 * rq] : acc0[4 * rq], a1 = cbi ? acc1[4 * rq + 1] : acc0[4 * rq + 1], a2 = cbi ? acc1[4 * rq + 2] : acc0[4 * rq + 2], a3 = cbi ? acc1[4 * rq + 3] : acc0[4 * rq + 3];
                u32x2 w; w.x = cvtpk(bflo(uu.x) * (a0 + bias), bfhi(uu.x) * (a1 + bias)); w.y = cvtpk(bflo(uu.y) * (a2 + bias), bfhi(uu.y) * (a3 + bias));
                *(u32x2*)(up + c) = w; }
        __syncthreads();
    }
}


#define RLX_AGENT __ATOMIC_RELAXED, __HIP_MEMORY_SCOPE_AGENT
#define XB_TMO      128
#define XB_XCNT(j)  (256  + 64 * (j))
#define XB_XSUB(j)  (1280 + 64 * (j))
#define XB_XGEN(j)  (2304 + 64 * (j))
#define XB_TOP      3328
#define XB_TOPGEN   3392
#define XCD_BAR_WORDS 3456
#define XB_SPIN_CAP (1u << 18)

__device__ __forceinline__ unsigned xb_ld(unsigned* p)              { return __hip_atomic_load(p, __ATOMIC_RELAXED, __HIP_MEMORY_SCOPE_AGENT); }
__device__ __forceinline__ unsigned xb_add(unsigned* p, unsigned v) { return __hip_atomic_fetch_add(p, v, __ATOMIC_RELAXED, __HIP_MEMORY_SCOPE_AGENT); }
__device__ __forceinline__ unsigned xb_xcc_id() { return (unsigned)__builtin_amdgcn_s_getreg((3 << 11) | 20) & 0xFu; }
#define XB_SPIN(cond, bar) do { unsigned _sp = 0; while (cond) { __builtin_amdgcn_s_sleep(1); \
    if ((++_sp & 255u) == 0u) { if (xb_ld(&(bar)[XB_TMO])) break; if (_sp > XB_SPIN_CAP) { atomicAdd(&(bar)[XB_TMO], 1u); break; } } } } while (0)

struct XcdBarrier {
    unsigned* bar; unsigned x;
    volatile LAS unsigned* st;
};

__device__ __forceinline__ XcdBarrier xcd_barrier_post(unsigned* bar, volatile LAS unsigned* st) {
    XcdBarrier b; b.bar = bar; b.x = xb_xcc_id(); b.st = st;
    if (threadIdx.x == 0) (void)xb_add(&bar[XB_XCNT(b.x)], 1u);
    return b;
}
__device__ __forceinline__ void xcd_barrier_complete(unsigned* bar, unsigned x, unsigned& nloc, unsigned& nx) {
    const unsigned G = gridDim.x * gridDim.y * gridDim.z;
    unsigned sum, cnt, mine, sp = 0u;
    for (;;) {
        sum = 0u; cnt = 0u; mine = 0u;
#pragma unroll
        for (unsigned j = 0; j < 16; ++j) { const unsigned c = xb_ld(&bar[XB_XCNT(j)]); sum += c; cnt += (c > 0u) ? 1u : 0u; mine = (j == x) ? c : mine; }
        if (sum == G) break;
        __builtin_amdgcn_s_sleep(1);
        if ((++sp & 255u) == 0u) { if (xb_ld(&bar[XB_TMO])) break; if (sp > XB_SPIN_CAP) { atomicAdd(&bar[XB_TMO], 1u); break; } }
    }
    nloc = mine > 0u ? mine : 1u; nx = cnt > 0u ? cnt : 1u;
}

__device__ __forceinline__ void xcd_barrier(const XcdBarrier& b) {
    asm volatile("s_waitcnt vmcnt(0)" ::: "memory");
    __syncthreads();
    if (threadIdx.x == 0) {
        unsigned* bar = b.bar;
        __builtin_amdgcn_s_waitcnt(0);
        unsigned nloc = b.st[0], nx = b.st[1];
        if (nloc == 0u) { xcd_barrier_complete(bar, b.x, nloc, nx); b.st[0] = nloc; b.st[1] = nx; }
        const unsigned old = xb_add(&bar[XB_XSUB(b.x)], 1u);
        const unsigned gen = old / nloc;
        if (old + 1u == (gen + 1u) * nloc) {
            __builtin_amdgcn_fence(__ATOMIC_RELEASE, "agent");
            asm volatile("s_waitcnt vmcnt(0)" ::: "memory");
            const unsigned og = xb_add(&bar[XB_TOP], 1u);
            const unsigned tg = og / nx;
            if (og + 1u == (tg + 1u) * nx) xb_add(&bar[XB_TOPGEN], 1u);
            else XB_SPIN(xb_ld(&bar[XB_TOPGEN]) == tg, bar);
            __builtin_amdgcn_fence(__ATOMIC_ACQUIRE, "agent");
            xb_add(&bar[XB_XGEN(b.x)], 1u);
            asm volatile("s_waitcnt vmcnt(0)" ::: "memory");
        } else {
            XB_SPIN(xb_ld(&bar[XB_XGEN(b.x)]) == gen, bar);
            __builtin_amdgcn_fence(__ATOMIC_ACQUIRE, "agent");
            asm volatile("s_waitcnt vmcnt(0)" ::: "memory");
        }
    }
    __syncthreads();
}
struct Args { const float* in[29]; float* out; unsigned char* ws; int ph_lo, ph_hi; };
constexpr int NPHASE = 15;

__global__ void __launch_bounds__(512, 2) mega_fwd(Args args) {
    extern __shared__ __attribute__((aligned(16))) unsigned char lds_raw[];
    LAS unsigned char* lds = (LAS unsigned char*)lds_raw;
    cg::grid_group grid = cg::this_grid();
    const int tid = threadIdx.x, lane = tid & 63, wid = __builtin_amdgcn_readfirstlane(tid >> 6);
    const int G = gridDim.x, bx = blockIdx.x;
    const int gw = bx * 8 + wid, NGW = G * 8, gt = bx * 512 + tid, NGT = G * 512;
    unsigned char* ws = args.ws;
    const float* x_in = args.in[0];
    float* R = args.out;
    bf16_t* WGU = (bf16_t*)(ws + WS_WGU); bf16_t* WD = (bf16_t*)(ws + WS_WD); bf16_t* WIN = (bf16_t*)(ws + WS_WIN);
    bf16_t* WA = (bf16_t*)(ws + WS_WA); bf16_t* WB = (bf16_t*)(ws + WS_WB); bf16_t* WOUT = (bf16_t*)(ws + WS_WOUT); bf16_t* WG = (bf16_t*)(ws + WS_WG); bf16_t* WP = (bf16_t*)(ws + WS_WP);
    bf16_t* XB = (bf16_t*)(ws + WS_XB); bf16_t* PB = (bf16_t*)(ws + WS_PB);
    bf16_t* PROJ = (bf16_t*)(ws + WS_BIG); bf16_t* HB = (bf16_t*)(ws + WS_BIG); bf16_t* PE = (bf16_t*)(ws + WS_PE); bf16_t* VT = (bf16_t*)(ws + WS_VT);
    const int lo = args.ph_lo, hi = args.ph_hi;
    volatile LAS unsigned* bst = (volatile LAS unsigned*)(lds + LDS_BYTES - 64);
    if (tid < 16) bst[tid] = 0u;
    __syncthreads();
    XcdBarrier bar = xcd_barrier_post((unsigned*)(ws + WS_CTL), bst);
#ifndef PHMASK
#define PHMASK 0x7fff
#endif
#define IN(k) (((PHMASK >> (k)) & 1) && lo <= (k) && (k) < hi)
#define SEAM(k) do { if (IN(k) && IN((k) + 1)) { if ((k) == 0) grid.sync(); else xcd_barrier(bar); } } while (0)
    LAS float* scr = (LAS float*)(lds + wid * 16640);

    if (IN(0)) {
        transpose_w(args.in[2], DM, 2 * DFF, WGU, MapGU(), scr, gw, NGW, lane);
        transpose_w(args.in[3], DFF, DM, WD, MapId(), scr, (gw + 512) % NGW, NGW, lane);
        transpose_w(args.in[6], DM, 9216, WIN, MapIn(), scr, gw, NGW, lane);
        transpose_w(args.in[16], 1024, DM, WA, MapId(), scr, (gw + 1024) % NGW, NGW, lane);
        transpose_w(args.in[17], 1024, DM, WB, MapId(), scr, (gw + 1536) % NGW, NGW, lane);
        transpose_w(args.in[18], DM, DM, WOUT, MapId(), scr, gw, NGW, lane);
        transpose_w(args.in[25], DM, DM, WG, MapId(), scr, gw, NGW, lane);
        transpose_w(args.in[26], PDIM, DM, WP, MapId(), scr, (gw + 768) % NGW, NGW, lane);
        cvt_flat(x_in, XB, (size_t)MROWS * DM, gt, NGT);
        cvt_flat(args.in[1], PB, (size_t)MROWS * PDIM, gt, NGT);
    }
    SEAM(0);
    if (IN(1)) { pg8::Gemm g{XB, WGU, MROWS, 2 * DFF, DM, DM, DM}; pg8::StaticOrder S; S.init(MROWS, 2 * DFF, G, bx); pg8::EpiSwiGLU E{HB, DFF}; pg8::gemm_phase(lds, g, S, E); }
    SEAM(1);
    if (IN(2)) { pg8::Gemm g{HB, WD, MROWS, DM, DFF, DFF, DFF}; pg8::StaticOrder S; S.init(MROWS, DM, G, bx); pg8::EpiRes<0> E{x_in, R, nullptr, DM, ALPHA, 0.5f}; pg8::gemm_phase(lds, g, S, E); }
    SEAM(2);
    if (IN(3)) {
        for (int r = gw; r < MROWS; r += NGW) ln_row<true>(R + (size_t)r * DM, args.in[4], args.in[5], XB + (size_t)r * DM, lane);
        transpose_w(args.in[21], DM, 2 * DFF, WGU, MapGU(), scr, gw, NGW, lane);
        transpose_w(args.in[22], DFF, DM, WD, MapId(), scr, (gw + 512) % NGW, NGW, lane);
    }
    SEAM(3);
    if (IN(4)) {
        { pg8::Gemm g{XB, WIN, MROWS, PCOLS, DM, DM, DM}; pg8::StaticOrder S; S.init(MROWS, PCOLS, G, bx); pg8::EpiProj E{PROJ, PCOLS}; pg8::gemm_phase(lds, g, S, E); }
        { pg8::Gemm g{WIN + (size_t)8192 * DM, XB, 1024, MROWS, DM, DM, DM}; pg8::StaticOrder S; S.init(1024, MROWS, G, bx); pg8::EpiBf16 E{VT, MROWS}; pg8::gemm_phase(lds, g, S, E); }
    }
    SEAM(4);
    if (IN(5)) {
        float lam;
        { const float a = args.in[11][lane] * args.in[12][lane], c = args.in[13][lane] * args.in[14][lane];
          lam = __expf(wave_sum(a)) - __expf(wave_sum(c)) + 0.2f; }
#pragma unroll 1
        for (int it = 0; it < 4; ++it) { const int pid = bx + G * (it >> 1); if (pid >= 512) break; const int bh = pid >> 4, s = pid & 15;
            att::attn_unit(lds, PROJ, VT, args.in[15], lam, bh >> 3, bh & 7, (it & 1) ? s : 31 - s, tid, wid, lane); }
        for (int un = bx; un < 512; un += G) sgu_unit(lds, PROJ, args.in[7], args.in[8], args.in[9], args.in[10], un >> 2, un & 3, tid, wid, lane);
    }
    SEAM(5);
    if (IN(6)) { pg8::Gemm g{PROJ + PC_U, WA, MROWS, DM, 1024, PCOLS, 1024}; pg8::StaticOrder S; S.init(MROWS, DM, G, bx); pg8::EpiGate E{PROJ + PC_GA, nullptr, PROJ + PC_GA, PCOLS}; pg8::gemm_phase(lds, g, S, E); }
    SEAM(6);
    if (IN(7)) { pg8::Gemm g{PROJ + PC_Q, WB, MROWS, DM, 1024, PCOLS, 1024}; pg8::StaticOrder S; S.init(MROWS, DM, G, bx); pg8::EpiGate E{PROJ + PC_GB, PROJ + PC_GA, PROJ + PC_GA, PCOLS}; pg8::gemm_phase(lds, g, S, E); }
    SEAM(7);
    if (IN(8)) { pg8::Gemm g{PROJ + PC_GA, WOUT, MROWS, DM, DM, PCOLS, DM}; pg8::StaticOrder S; S.init(MROWS, DM, G, bx); pg8::EpiRes<0> E{R, R, nullptr, DM, ALPHA, 1.0f}; pg8::gemm_phase(lds, g, S, E); }
    SEAM(8);
    if (IN(9)) { for (int r = gw; r < MROWS; r += NGW) ln_row<true>(R + (size_t)r * DM, args.in[19], args.in[20], XB + (size_t)r * DM, lane); }
    SEAM(9);
    if (IN(10)) {
        { pg8::Gemm g{PB, WP, MROWS, DM, PDIM, PDIM, PDIM}; pg8::StaticOrder S; S.init(MROWS, DM, G, bx); pg8::EpiBf16 E{PE, DM}; pg8::gemm_phase(lds, g, S, E); }
        { pg8::Gemm g{XB, WGU, MROWS, 2 * DFF, DM, DM, DM}; pg8::StaticOrder S; S.init(MROWS, 2 * DFF, G, bx); pg8::EpiSwiGLU E{HB, DFF}; pg8::gemm_phase(lds, g, S, E); }
    }
    SEAM(10);
    if (IN(11)) { pg8::Gemm g{HB, WD, MROWS, DM, DFF, DFF, DFF}; pg8::StaticOrder S; S.init(MROWS, DM, G, bx); pg8::EpiRes<0> E{R, R, nullptr, DM, ALPHA, 0.5f}; pg8::gemm_phase(lds, g, S, E); }
    SEAM(11);
    if (IN(12)) { for (int r = gw; r < MROWS; r += NGW) ln_row<true>(R + (size_t)r * DM, args.in[23], args.in[24], XB + (size_t)r * DM, lane); }
    SEAM(12);
    if (IN(13)) { pg8::Gemm g{XB, WG, MROWS, DM, DM, DM, DM}; pg8::StaticOrder S; S.init(MROWS, DM, G, bx); pg8::EpiRes<1> E{R, R, PE, DM, ALPHA, 1.0f}; pg8::gemm_phase(lds, g, S, E); }
    SEAM(13);
    if (IN(14)) { for (int r = gw; r < MROWS; r += NGW) ln_row<false>(R + (size_t)r * DM, args.in[27], args.in[28], nullptr, lane); }
#undef IN
#undef SEAM
}

#ifndef MK_SPLIT
#define MK_SPLIT 0
#endif
extern "C" void kernel_launch(void* const* d_in, const int* in_sizes, int n_in, void* d_out, int out_size, void* d_ws, size_t ws_size, hipStream_t stream) {
    static int grid = 0;
    if (grid == 0) {
        if (n_in != 29 || out_size != MROWS * DM || ws_size < WS_END) { fprintf(stderr, "kernel_launch: unexpected shapes (n_in %d out %d ws %zu)\n", n_in, out_size, ws_size); grid = -1; return; }
        int dev = 0, cus = 0, per_cu = 0;
        hipGetDevice(&dev); hipDeviceGetAttribute(&cus, hipDeviceAttributeMultiprocessorCount, dev);
        if (hipFuncSetAttribute((const void*)mega_fwd, hipFuncAttributeMaxDynamicSharedMemorySize, LDS_BYTES) != hipSuccess) { fprintf(stderr, "kernel_launch: hipFuncSetAttribute failed\n"); grid = -1; return; }
        if (hipOccupancyMaxActiveBlocksPerMultiprocessor(&per_cu, (const void*)mega_fwd, 512, LDS_BYTES) != hipSuccess || per_cu < 1) { fprintf(stderr, "kernel_launch: occupancy query gave %d\n", per_cu); per_cu = 1; }
        (void)hipGetLastError();
        grid = cus * 1;
    }
    if (grid < 0) return;
    if (hipMemsetAsync((char*)d_ws + WS_CTL, 0, CTL_ZERO_BYTES, stream) != hipSuccess) { fprintf(stderr, "kernel_launch: memset failed\n"); return; }
    Args a{};
    for (int i = 0; i < 29; ++i) a.in[i] = (const float*)d_in[i];
    a.out = (float*)d_out; a.ws = (unsigned char*)d_ws;
#if MK_SPLIT
    for (int p = 0; p < NPHASE; ++p) { a.ph_lo = p; a.ph_hi = p + 1; hipLaunchKernelGGL(mega_fwd, dim3(grid), dim3(512), LDS_BYTES, stream, a); }
#else
    a.ph_lo = 0; a.ph_hi = NPHASE;
    void* kargs[] = {&a};
    hipError_t e = hipLaunchCooperativeKernel((const void*)mega_fwd, dim3(grid), dim3(512), kargs, LDS_BYTES, stream);
    if (e != hipSuccess) fprintf(stderr, "cooperative launch failed: %s (grid %d)\n", hipGetErrorString(e), grid);
#endif
}
```
